# Optimizing an MI355X kernel written in HIP

```python
import jax, jax.numpy as jnp
from jax import lax
import numpy as np

D_MODEL = 1024
BATCH = 8
SEQ = 4096
DEPTH = 1

GRID_W = 64
ATTN_HEADS = 8
ATTN_KV_HEADS = 2
ATTN_HEAD_DIM = 64
RET_HEADS = 4
RET_KEY_DIM = 64
RET_VALUE_DIM = 128
Q_BLOCK = 128
RET_CHUNK = 128
ROPE_THETA = 10000.0
EPS = 1e-6

ATTN_WIDTH = ATTN_HEADS * ATTN_HEAD_DIM
ATTN_KV_WIDTH = ATTN_KV_HEADS * ATTN_HEAD_DIM
RET_QK_WIDTH = RET_HEADS * RET_KEY_DIM
RET_V_WIDTH = RET_HEADS * RET_VALUE_DIM
MERGE_WIDTH = 2 * D_MODEL
IN_SIZES = (ATTN_WIDTH, ATTN_KV_WIDTH, ATTN_KV_WIDTH, ATTN_WIDTH,
            RET_QK_WIDTH, RET_QK_WIDTH, RET_V_WIDTH, RET_V_WIDTH, MERGE_WIDTH)
IN_WIDTH = int(sum(IN_SIZES))
IN_SPLITS = tuple(int(s) for s in np.cumsum(IN_SIZES)[:-1])

kernel_name = "hybrid_gqa_axialrope_bidir_retention_gated_merge"


def rmsnorm(x, g):
    xf = x.astype(jnp.float32)
    xf = xf * lax.rsqrt(jnp.mean(xf * xf, axis=-1, keepdims=True) + EPS)
    return xf.astype(x.dtype) * g


def axial_rope_tables(seq_len, head_dim):
    rows = seq_len // GRID_W
    r, cidx = jnp.meshgrid(jnp.arange(rows), jnp.arange(GRID_W), indexing='ij')
    row = r.reshape(-1).astype(jnp.float32)
    col = cidx.reshape(-1).astype(jnp.float32)
    half = head_dim // 2
    inv_freq = ROPE_THETA ** (-jnp.arange(0, half, 2, dtype=jnp.float32) / half)
    ang_r = row[:, None] * inv_freq[None, :]
    ang_c = col[:, None] * inv_freq[None, :]
    return (jnp.cos(ang_r), jnp.sin(ang_r), jnp.cos(ang_c), jnp.sin(ang_c))


def _rotate(xp, cos, sin):
    x1, x2 = jnp.split(xp, 2, axis=-1)
    cos = cos[None, :, None, :].astype(xp.dtype)
    sin = sin[None, :, None, :].astype(xp.dtype)
    return jnp.concatenate([x1 * cos - x2 * sin, x2 * cos + x1 * sin], axis=-1)


def apply_axial_rope(x, tables):
    cos_r, sin_r, cos_c, sin_c = tables
    xr, xc = jnp.split(x, 2, axis=-1)
    return jnp.concatenate([_rotate(xr, cos_r, sin_r), _rotate(xc, cos_c, sin_c)], axis=-1)


def gqa_attention(q, k, v, qn_g, kn_g, tables):
    B, S = q.shape[0], q.shape[1]
    G = ATTN_HEADS // ATTN_KV_HEADS
    q = apply_axial_rope(rmsnorm(q, qn_g), tables) * (ATTN_HEAD_DIM ** -0.5)
    k = apply_axial_rope(rmsnorm(k, kn_g), tables)
    nblk = S // Q_BLOCK
    qb = q.reshape(B, nblk, Q_BLOCK, ATTN_KV_HEADS, G, ATTN_HEAD_DIM).transpose(1, 0, 2, 3, 4, 5)

    def block(qi):
        s = jnp.einsum('bqkgd,bskd->bkgqs', qi, k).astype(jnp.float32)
        p = jax.nn.softmax(s, axis=-1).astype(v.dtype)
        return jnp.einsum('bkgqs,bskd->bqkgd', p, v)

    o = lax.map(block, qb)
    return o.transpose(1, 0, 2, 3, 4, 5).reshape(B, S, ATTN_WIDTH)


def retention_one_direction(q, k, v, log_gamma, strict):
    B, S, H, dk = q.shape
    dv = v.shape[-1]
    C = RET_CHUNK
    N = S // C
    dt = q.dtype
    qc = q.reshape(B, N, C, H, dk)
    kc = k.reshape(B, N, C, H, dk)
    vc = v.reshape(B, N, C, H, dv)
    idx = jnp.arange(C, dtype=jnp.float32)
    diff = idx[:, None] - idx[None, :]
    mask = (diff > 0) if strict else (diff >= 0)
    decay_intra = jnp.where(mask[None], jnp.exp(log_gamma[:, None, None] * jnp.maximum(diff, 0.0)[None]), 0.0)
    scores = jnp.einsum('bnihd,bnjhd->bnhij', qc, kc) * decay_intra.astype(dt)[None, None]
    o_intra = jnp.einsum('bnhij,bnjhe->bnihe', scores, vc)
    k_dec = jnp.exp(log_gamma[None, :] * (C - 1 - idx)[:, None]).astype(dt)
    kv = jnp.einsum('bnjhd,bnjhe->nbhde', kc * k_dec[:, :, None], vc)
    chunk_decay = jnp.exp(log_gamma * C).astype(kv.dtype)[None, :, None, None]

    def step(R, kv_n):
        return chunk_decay * R + kv_n, R

    _, R_prev = lax.scan(step, jnp.zeros_like(kv[0]), kv)
    q_dec = jnp.exp(log_gamma[None, :] * (idx + 1.0)[:, None]).astype(dt)
    o_inter = jnp.einsum('bnihd,nbhde->bnihe', qc * q_dec[:, :, None], R_prev)
    return (o_intra + o_inter).reshape(B, S, H, dv)


def bidirectional_retention(q, k, v, w_dec_f, w_dec_b, gn_g, tables):
    B, S = q.shape[0], q.shape[1]
    q = apply_axial_rope(q, tables)
    k = apply_axial_rope(k, tables) * (RET_KEY_DIM ** -0.5)
    lg_f = jax.nn.log_sigmoid(w_dec_f.astype(jnp.float32))
    lg_b = jax.nn.log_sigmoid(w_dec_b.astype(jnp.float32))
    o_f = retention_one_direction(q, k, v, lg_f, False)
    o_b = jnp.flip(retention_one_direction(jnp.flip(q, 1), jnp.flip(k, 1), jnp.flip(v, 1), lg_b, True), 1)
    o = (o_f + o_b).astype(jnp.float32)
    mu = jnp.mean(o, axis=-1, keepdims=True)
    var = jnp.mean(jnp.square(o - mu), axis=-1, keepdims=True)
    o = ((o - mu) * lax.rsqrt(var + EPS)).astype(v.dtype)
    return o.reshape(B, S, RET_V_WIDTH) * gn_g


def setup_inputs(seed: int = 0) -> dict:
    key = jax.random.key(seed)
    ks = jax.random.split(key, 20)
    f32 = jnp.float32

    def w(k, shape, fan_in):
        return jax.random.normal(k, shape, f32) * (fan_in ** -0.5)

    def gain(k, shape):
        return 1.0 + 0.05 * jax.random.normal(k, shape, f32)

    base = jnp.log(2.0 ** (5.0 + jnp.arange(RET_HEADS, dtype=f32)) - 1.0)
    return {
        "x": jax.random.normal(ks[0], (BATCH, SEQ, D_MODEL), f32),
        "c": jax.random.normal(ks[1], (BATCH, D_MODEL), f32),
        "w_ada": w(ks[2], (DEPTH, D_MODEL, 3 * D_MODEL), D_MODEL) * 0.5,
        "b_ada": 0.02 * jax.random.normal(ks[3], (DEPTH, 3 * D_MODEL), f32),
        "g_pre": gain(ks[4], (DEPTH, D_MODEL)),
        "w_in": w(ks[5], (DEPTH, D_MODEL, IN_WIDTH), D_MODEL),
        "qn_g": gain(ks[6], (DEPTH, ATTN_HEAD_DIM)),
        "kn_g": gain(ks[7], (DEPTH, ATTN_HEAD_DIM)),
        "w_dec_f": base[None] + 0.1 * jax.random.normal(ks[8], (DEPTH, RET_HEADS), f32),
        "w_dec_b": base[None] + 0.1 * jax.random.normal(ks[9], (DEPTH, RET_HEADS), f32),
        "gn_g": gain(ks[10], (DEPTH, RET_V_WIDTH)),
        "w_pa": w(ks[11], (DEPTH, ATTN_WIDTH, D_MODEL), ATTN_WIDTH),
        "w_pr": w(ks[12], (DEPTH, RET_V_WIDTH, D_MODEL), RET_V_WIDTH),
        "w_out": w(ks[13], (DEPTH, D_MODEL, D_MODEL), D_MODEL),
        "g_post": gain(ks[14], (DEPTH, D_MODEL)),
    }


def reference(x, c, w_ada, b_ada, g_pre, w_in, qn_g, kn_g, w_dec_f, w_dec_b, gn_g,
              w_pa, w_pr, w_out, g_post):
    B, S, D = x.shape
    tables = axial_rope_tables(S, ATTN_HEAD_DIM)
    c_act = jax.nn.silu(c)
    for l in range(DEPTH):
        mod = c_act @ w_ada[l] + b_ada[l]
        shift, scale, gate = jnp.split(mod, 3, axis=-1)
        h = rmsnorm(x, g_pre[l]) * (1.0 + scale[:, None, :]) + shift[:, None, :]
        p = h @ w_in[l]
        qa, ka, va, za, qr, kr, vr, zr, gl = jnp.split(p, IN_SPLITS, axis=-1)
        ya = gqa_attention(qa.reshape(B, S, ATTN_HEADS, ATTN_HEAD_DIM),
                           ka.reshape(B, S, ATTN_KV_HEADS, ATTN_HEAD_DIM),
                           va.reshape(B, S, ATTN_KV_HEADS, ATTN_HEAD_DIM),
                           qn_g[l], kn_g[l], tables) * jax.nn.silu(za)
        yr = bidirectional_retention(qr.reshape(B, S, RET_HEADS, RET_KEY_DIM),
                                     kr.reshape(B, S, RET_HEADS, RET_KEY_DIM),
                                     vr.reshape(B, S, RET_HEADS, RET_VALUE_DIM),
                                     w_dec_f[l], w_dec_b[l], gn_g[l], tables) * jax.nn.silu(zr)
        g_att, g_ret = jnp.split(jax.nn.sigmoid(gl), 2, axis=-1)
        merged = g_att * (ya @ w_pa[l]) + g_ret * (yr @ w_pr[l])
        y = rmsnorm(merged @ w_out[l], g_post[l])
        x = x + gate[:, None, :] * y
    return x
```

```cpp
#include <hip/hip_runtime.h>
#include <hip/hip_bf16.h>
#include <cstdio>
#include <cstdint>
#include <cmath>
namespace pg8 {
#define PG8_LAS __attribute__((address_space(3)))
typedef unsigned short bf16_t;
typedef short bf16x8 __attribute__((ext_vector_type(8)));
typedef float f32x4 __attribute__((ext_vector_type(4)));
typedef unsigned u32x4 __attribute__((ext_vector_type(4)));
constexpr int BM = 256, BK = 64, HALF = 128, HTB = HALF * BK * 2  , STAGE_BYTES = 8 * HTB, NXCD = 8, WGM = 8;

__host__ __device__ __forceinline__ int lds_byte(int r, int c) { const int st = (r >> 4) * 2 + (c >> 5), rr = r & 15, cc = c & 31, ob = rr * 64 + cc * 2; return st * 1024 + (ob ^ (((ob >> 9) & 1) << 5)); }
__host__ __device__ __forceinline__ void stage_rc(int b, int& R, int& C) { const int st = b / 1024, sb = b % 1024, swz = sb ^ (((sb >> 9) & 1) << 5); R = (st >> 1) * 16 + swz / 64; C = (st & 1) * 32 + (swz % 64) / 2; }
__host__ __device__ __forceinline__ int perm32(int rho) { const int n = rho >> 4, i = rho & 15; return 8 * (i >> 2) + 4 * n + (i & 3); }

struct Unit { int pm, pn; };
struct Gemm { const bf16_t* A; const bf16_t* Bt; int M, N, K; };

struct StaticOrder {
    int nM, nN, nwg, G, c;
    __host__ __device__ void init(int M, int N, int G_, int c_) { nM = M / BM; nN = N / BM; nwg = nM * nN; G = G_; c = c_; }
    __host__ __device__ bool next(int i, Unit& u) const {
        const long L = (long)i * G + c; if (L >= nwg) return false;
        int wgid = (int)L; { const int q = nwg / NXCD, r = nwg % NXCD, xcd = wgid % NXCD, off = wgid / NXCD; wgid = (xcd < r ? xcd * (q + 1) : r * (q + 1) + (xcd - r) * q) + off; }
        const int nig = WGM * nN, gid = wgid / nig, fm = gid * WGM, gsz = (nM - fm) < WGM ? (nM - fm) : WGM;
        u.pm = fm + ((wgid % nig) % gsz); u.pn = (wgid % nig) / gsz; return true;
    }
    __device__ __forceinline__ void a_ready(const Unit&) const {}
    __device__ __forceinline__ void done(const Unit&) const {}
};

__device__ __forceinline__ unsigned cvt_pk_bf16(float lo, float hi) { unsigned r; asm volatile("v_cvt_pk_bf16_f32 %0, %1, %2" : "=v"(r) : "v"(lo), "v"(hi)); return r; }
typedef float f32x2 __attribute__((ext_vector_type(2)));
template <class Epi, class Sched, bool ALIGN_EPI = false, bool SP2 = false>
__device__ __forceinline__ void gemm_phase(PG8_LAS unsigned char* lds, const Gemm g, const Sched& S, const Epi& E) {
    int tid = threadIdx.x; asm volatile("" : "+v"(tid));
    const int wid = __builtin_amdgcn_readfirstlane(tid >> 6), lane = tid & 63, wr = wid >> 2, wc = wid & 3, fr = lane & 15, fq = lane >> 4;
    const int K = g.K, nt = K / BK;
    unsigned voffA[2], voffB[2];
#pragma unroll
    for (int i = 0; i < 2; ++i) { int R, C; stage_rc(tid * 16 + i * 8192, R, C); const int Rb = Epi::PERM ? ((R & ~31) + perm32(R & 31)) : R;
        voffA[i] = (unsigned)(R * K + C) * 2u; voffB[i] = (unsigned)(Rb * K + C) * 2u; }
    const size_t kstep = (size_t)(BK * 2);
    const size_t hstep = (size_t)HALF * K * 2;
    const size_t tstep = 2 * hstep;
    const unsigned ldsw = (unsigned)wid * 1024u;
    const int aoff = lds_byte(wr * 64 + fr, fq * 8), boff = lds_byte(wc * 32 + fr, fq * 8);
#define PG8_SA(b, h) (((b) * 2 + (h)) * HTB)
#define PG8_SB(b, h) ((4 + (b) * 2 + (h)) * HTB)
#define PG8_STAGE(bufoff, gbase, voff) do { _Pragma("unroll") for (int _i = 0; _i < 2; ++_i) \
        __builtin_amdgcn_global_load_lds((const unsigned*)((const char*)(gbase) + (voff)[_i]), (PG8_LAS unsigned*)(lds + (bufoff) + ldsw + _i * 8192), 16, 0, 0); } while (0)
#define PG8_LDA(dst, b, h) do { _Pragma("unroll") for (int m = 0; m < 4; ++m) _Pragma("unroll") for (int k = 0; k < 2; ++k) dst[m][k] = *(const PG8_LAS bf16x8*)(lds + PG8_SA(b, h) + aoff + m * 2048 + k * 1024); } while (0)
#define PG8_LDB(dst, b, h) do { _Pragma("unroll") for (int n = 0; n < 2; ++n) _Pragma("unroll") for (int k = 0; k < 2; ++k) dst[n][k] = *(const PG8_LAS bf16x8*)(lds + PG8_SB(b, h) + boff + n * 2048 + k * 1024); } while (0)
#define PG8_MMA(ai, bj, At, Bt) do { __builtin_amdgcn_s_setprio(1); _Pragma("unroll") for (int m = 0; m < 4; ++m) _Pragma("unroll") for (int n = 0; n < 2; ++n) _Pragma("unroll") for (int k = 0; k < 2; ++k) \
        acc[ai][bj][m][n] = __builtin_amdgcn_mfma_f32_16x16x32_bf16(Bt[n][k], At[m][k], acc[ai][bj][m][n], 0, 0, 0); __builtin_amdgcn_s_setprio(0); } while (0)
#define PG8_WAIT_V(n) asm volatile("s_waitcnt vmcnt(" #n ")" ::: "memory")
#define PG8_WAIT_L(n) asm volatile("s_waitcnt lgkmcnt(" #n ")" ::: "memory")
#define PG8_BAR __builtin_amdgcn_s_barrier()
#define PG8_SCHED __builtin_amdgcn_sched_barrier(0)
    Unit cur, nxt; int ui = 0;
    if (!S.next(0, cur)) return;
    f32x4 acc[2][2][4][2];
#pragma unroll
    for (int a = 0; a < 2; ++a)
#pragma unroll
        for (int b = 0; b < 2; ++b)
#pragma unroll
            for (int m = 0; m < 4; ++m)
#pragma unroll
                for (int n = 0; n < 2; ++n) acc[a][b][m][n] = (f32x4){0.f, 0.f, 0.f, 0.f};
    bf16x8 At[4][2], B0[2][2], B1[2][2];
    const char* cA = (const char*)g.A + (size_t)cur.pm * tstep; const char* cB = (const char*)g.Bt + (size_t)cur.pn * tstep;
    S.a_ready(cur);
    if constexpr (SP2) {
        PG8_STAGE(PG8_SB(0, 0), cB, voffB); PG8_STAGE(PG8_SB(0, 1), cB + hstep, voffB); PG8_STAGE(PG8_SA(0, 0), cA, voffA); PG8_STAGE(PG8_SA(0, 1), cA + hstep, voffA);
        if (wr == 1) PG8_BAR;
        PG8_WAIT_V(2); PG8_BAR;
        PG8_STAGE(PG8_SB(1, 0), cB + kstep, voffB); PG8_STAGE(PG8_SA(1, 0), cA + kstep, voffA); PG8_STAGE(PG8_SB(1, 1), cB + hstep + kstep, voffB);
        PG8_WAIT_V(6); PG8_BAR;
    } else {
        PG8_STAGE(PG8_SB(0, 0), cB, voffB); PG8_STAGE(PG8_SA(0, 0), cA, voffA); PG8_STAGE(PG8_SB(0, 1), cB + hstep, voffB); PG8_STAGE(PG8_SA(0, 1), cA + hstep, voffA);
        if (wr == 1) PG8_BAR;
        PG8_WAIT_V(4); PG8_BAR;
        PG8_STAGE(PG8_SB(1, 0), cB + kstep, voffB); PG8_STAGE(PG8_SA(1, 0), cA + kstep, voffA); PG8_STAGE(PG8_SB(1, 1), cB + hstep + kstep, voffB);
        PG8_WAIT_V(6); PG8_BAR;
    }
    for (;;) {
        const bool has_next = S.next(ui + 1, nxt);
        const char* nA = has_next ? (const char*)g.A + (size_t)nxt.pm * tstep : cA; const char* nB = has_next ? (const char*)g.Bt + (size_t)nxt.pn * tstep : cB;
        for (int t = 0; t < nt; t += 2) {
            const bool last = (t == nt - 2);
            const char* a1 = cA + (size_t)(t + 1) * kstep;
            const char* a2 = last ? nA : cA + (size_t)(t + 2) * kstep; const char* b2 = last ? nB : cB + (size_t)(t + 2) * kstep;
            const char* a3 = a2 + kstep; const char* b3 = b2 + kstep;
            if (last && has_next) S.a_ready(nxt);
            if constexpr (SP2) {
            PG8_LDB(B0, 0, 0); PG8_LDB(B1, 0, 1); PG8_SCHED; PG8_LDA(At, 0, 0); PG8_STAGE(PG8_SA(1, 1), a1 + hstep, voffA);
            PG8_WAIT_V(8); PG8_WAIT_L(0); PG8_BAR; PG8_MMA(0, 0, At, B0); PG8_MMA(0, 1, At, B1); PG8_BAR; PG8_SCHED;
            PG8_LDA(At, 0, 1); PG8_STAGE(PG8_SB(0, 0), b2, voffB); PG8_STAGE(PG8_SB(0, 1), b2 + hstep, voffB); PG8_STAGE(PG8_SA(0, 0), a2, voffA);
            PG8_WAIT_V(8); PG8_WAIT_L(0); PG8_BAR; PG8_MMA(1, 0, At, B0); PG8_MMA(1, 1, At, B1); PG8_BAR; PG8_SCHED;
            PG8_LDB(B0, 1, 0); PG8_LDB(B1, 1, 1); PG8_SCHED; PG8_LDA(At, 1, 0); PG8_STAGE(PG8_SA(0, 1), a2 + hstep, voffA);
            PG8_WAIT_V(8); PG8_WAIT_L(0); PG8_BAR; PG8_MMA(0, 0, At, B0); PG8_MMA(0, 1, At, B1); PG8_BAR; PG8_SCHED;
            PG8_LDA(At, 1, 1); PG8_STAGE(PG8_SB(1, 0), b3, voffB); PG8_STAGE(PG8_SB(1, 1), b3 + hstep, voffB); PG8_STAGE(PG8_SA(1, 0), a3, voffA);
            PG8_WAIT_V(8); PG8_WAIT_L(0); PG8_BAR; PG8_MMA(1, 0, At, B0); PG8_MMA(1, 1, At, B1); PG8_BAR; PG8_SCHED;
            } else {
            PG8_LDB(B0, 0, 0); PG8_SCHED; PG8_LDA(At, 0, 0); PG8_STAGE(PG8_SA(1, 1), a1 + hstep, voffA);
            PG8_WAIT_L(8); PG8_BAR; PG8_WAIT_L(0); PG8_MMA(0, 0, At, B0); PG8_BAR; PG8_SCHED;
            PG8_LDB(B1, 0, 1); PG8_STAGE(PG8_SB(0, 0), b2, voffB);
            PG8_BAR; PG8_WAIT_L(0); PG8_MMA(0, 1, At, B1); PG8_BAR;
            PG8_LDA(At, 0, 1); PG8_STAGE(PG8_SA(0, 0), a2, voffA);
            PG8_BAR; PG8_WAIT_L(0); PG8_MMA(1, 0, At, B0); PG8_BAR; PG8_SCHED;
            PG8_STAGE(PG8_SB(0, 1), b2 + hstep, voffB);
            PG8_WAIT_V(6); PG8_BAR; PG8_MMA(1, 1, At, B1); PG8_BAR;
            PG8_LDB(B0, 1, 0); PG8_SCHED; PG8_LDA(At, 1, 0); PG8_STAGE(PG8_SA(0, 1), a2 + hstep, voffA);
            PG8_WAIT_L(8); PG8_BAR; PG8_WAIT_L(0); PG8_MMA(0, 0, At, B0); PG8_BAR; PG8_SCHED;
            PG8_LDB(B1, 1, 1); PG8_STAGE(PG8_SB(1, 0), b3, voffB);
            PG8_BAR; PG8_WAIT_L(0); PG8_MMA(0, 1, At, B1); PG8_BAR;
            PG8_LDA(At, 1, 1); PG8_STAGE(PG8_SA(1, 0), a3, voffA);
            PG8_BAR; PG8_WAIT_L(0); PG8_MMA(1, 0, At, B0); PG8_BAR; PG8_SCHED;
            PG8_STAGE(PG8_SB(1, 1), b3 + hstep, voffB);
            PG8_WAIT_V(6); PG8_BAR; PG8_MMA(1, 1, At, B1); PG8_BAR;
            }
        }
        if constexpr (ALIGN_EPI) { if (wr == 0) PG8_BAR; }
        if constexpr (!Epi::AFTER_DRAIN) { E(acc, cur, wr, wc, fr, fq); S.done(cur); }
        if (!has_next) break;
#pragma unroll
        for (int a = 0; a < 2; ++a)
#pragma unroll
            for (int b = 0; b < 2; ++b)
#pragma unroll
                for (int m = 0; m < 4; ++m)
#pragma unroll
                    for (int n = 0; n < 2; ++n) acc[a][b][m][n] = (f32x4){0.f, 0.f, 0.f, 0.f};
        cur = nxt; cA = nA; cB = nB; ++ui;
        if constexpr (ALIGN_EPI) { if (wr == 1) PG8_BAR; }
    }
    PG8_WAIT_V(0);
    if constexpr (!ALIGN_EPI) { if (wr == 0) PG8_BAR; }
    PG8_BAR;
    if constexpr (Epi::AFTER_DRAIN) { E.fused(acc, cur, wr, wc, fr, fq, lds, wid, lane); S.done(cur); }
#undef PG8_SA
#undef PG8_SB
#undef PG8_STAGE
#undef PG8_LDA
#undef PG8_LDB
#undef PG8_MMA
#undef PG8_WAIT_V
#undef PG8_WAIT_L
#undef PG8_BAR
#undef PG8_SCHED
}
}

#ifndef PG8_SP2
#define PG8_SP2 true
#endif
#ifndef PG8_ALIGN
#define PG8_ALIGN true
#endif
namespace pg8 {
typedef float f32x2v __attribute__((ext_vector_type(2)));
constexpr float LOG2E = 1.4426950408889634f;
constexpr float ATT_C2 = 0.125f * LOG2E;
__device__ __forceinline__ float silu_f(float x) { return x * __builtin_amdgcn_rcpf(1.0f + __builtin_amdgcn_exp2f(-x * LOG2E)); }
__device__ __forceinline__ float sigm_f(float x) { return __builtin_amdgcn_rcpf(1.0f + __builtin_amdgcn_exp2f(-x * LOG2E)); }
__device__ __forceinline__ float bflo(unsigned u) { return __uint_as_float(u << 16); }
__device__ __forceinline__ float bfhi(unsigned u) { return __uint_as_float(u & 0xffff0000u); }

struct EpiIn {
    static constexpr bool PERM = false, AFTER_DRAIN = false;
    bf16_t *Q, *Kb, *Vb, *SZA, *RQ, *RK, *RV, *SZR, *G; const float *qn_g, *kn_g; const float* rope;
    __device__ __forceinline__ void operator()(const f32x4 (&acc)[2][2][4][2], const Unit& u, int wr, int wc, int fr, int fq) const {
        const int pn = u.pn, row0 = u.pm * BM + wr * 64 + fr;
        const bool ropet = (pn <= 1) || (pn == 5) || (pn == 6) || (pn == 2 && wc < 2);
        if (ropet) {
            const bool norm = pn <= 2; const float* gsrc = (pn <= 1) ? qn_g : kn_g;
            const float sc = (pn <= 1) ? ATT_C2 : (pn == 6 ? 0.125f : 1.0f);
            f32x4 gv[2][2];
#pragma unroll
            for (int bj = 0; bj < 2; ++bj)
#pragma unroll
                for (int n = 0; n < 2; ++n) gv[bj][n] = norm ? *(const f32x4*)(gsrc + 32 * bj + 16 * n + 4 * fq) : (f32x4){1.f, 1.f, 1.f, 1.f};
#pragma unroll
            for (int ai = 0; ai < 2; ++ai)
#pragma unroll
                for (int m = 0; m < 4; ++m) {
                    const int row = row0 + ai * HALF + m * 16, b = row >> 12, s = row & 4095;
                    f32x4 v[2][2];
#pragma unroll
                    for (int bj = 0; bj < 2; ++bj)
#pragma unroll
                        for (int n = 0; n < 2; ++n) v[bj][n] = acc[ai][bj][m][n];
                    if (norm) {
                        float ss = 0.f;
#pragma unroll
                        for (int bj = 0; bj < 2; ++bj)
#pragma unroll
                            for (int n = 0; n < 2; ++n) { const f32x4 x = v[bj][n]; ss += (x[0] * x[0] + x[1] * x[1]) + (x[2] * x[2] + x[3] * x[3]); }
                        ss += __shfl_xor(ss, 16); ss += __shfl_xor(ss, 32);
                        const float rs = __builtin_amdgcn_rsqf(ss * (1.0f / 64.0f) + 1e-6f);
#pragma unroll
                        for (int bj = 0; bj < 2; ++bj)
#pragma unroll
                            for (int n = 0; n < 2; ++n) v[bj][n] = v[bj][n] * rs * gv[bj][n];
                    }
                    bf16_t* dst;
                    if (pn <= 1) dst = Q + (size_t)row * 512 + (pn * 4 + wc) * 64;
                    else if (pn == 2) dst = Kb + ((size_t)(b * 2 + wc) * 4096 + s) * 64;
                    else if (pn == 5) dst = RQ + ((size_t)(b * 4 + wc) * 4096 + s) * 64;
                    else dst = RK + ((size_t)(b * 4 + wc) * 4096 + s) * 64;
#pragma unroll
                    for (int bj = 0; bj < 2; ++bj) {
                        const int pos = bj ? (s & 63) : (s >> 6);
                        const f32x4* rp = (const f32x4*)(rope + (size_t)(pos * 16 + 4 * fq) * 2);
                        const f32x4 c01 = rp[0], c23 = rp[1];
                        const f32x4 x1 = v[bj][0], x2 = v[bj][1];
                        const float a0 = (x1[0] * c01[0] - x2[0] * c01[1]) * sc, a1 = (x1[1] * c01[2] - x2[1] * c01[3]) * sc, a2 = (x1[2] * c23[0] - x2[2] * c23[1]) * sc, a3 = (x1[3] * c23[2] - x2[3] * c23[3]) * sc;
                        const float b0 = (x2[0] * c01[0] + x1[0] * c01[1]) * sc, b1 = (x2[1] * c01[2] + x1[1] * c01[3]) * sc, b2 = (x2[2] * c23[0] + x1[2] * c23[1]) * sc, b3 = (x2[3] * c23[2] + x1[3] * c23[3]) * sc;
                        u32x4 w; w.x = cvt_pk_bf16(a0, a1); w.y = cvt_pk_bf16(a2, a3); w.z = cvt_pk_bf16(b0, b1); w.w = cvt_pk_bf16(b2, b3);
                        *(u32x4*)(dst + 32 * bj + 8 * fq) = w;
                    }
                }
        } else {
            const int act = (pn == 2 || pn == 7 || pn == 8) ? 0 : (pn >= 11 ? 2 : 1);
#pragma unroll
            for (int ai = 0; ai < 2; ++ai)
#pragma unroll
                for (int m = 0; m < 4; ++m) {
                    const int row = row0 + ai * HALF + m * 16, b = row >> 12, s = row & 4095;
#pragma unroll
                    for (int bj = 0; bj < 2; ++bj) {
                        f32x4 v0 = acc[ai][bj][m][0], v1 = acc[ai][bj][m][1];
                        if (act == 1) {
#pragma unroll
                            for (int i = 0; i < 4; ++i) { v0[i] = silu_f(v0[i]); v1[i] = silu_f(v1[i]); }
                        } else if (act == 2) {
#pragma unroll
                            for (int i = 0; i < 4; ++i) { v0[i] = sigm_f(v0[i]); v1[i] = sigm_f(v1[i]); }
                        }
                        const int colw = 64 * wc + 32 * bj + 8 * fq;
                        bf16_t* dst;
                        if (pn == 2) dst = Vb + ((size_t)(b * 2 + (wc - 2)) * 4096 + s) * 64 + 32 * bj + 8 * fq;
                        else if (pn <= 4) dst = SZA + (size_t)row * 512 + (pn - 3) * 256 + colw;
                        else if (pn <= 8) { const int c = (pn - 7) * 256 + colw; dst = RV + ((size_t)(b * 4 + (c >> 7)) * 4096 + s) * 128 + (c & 127); }
                        else if (pn <= 10) dst = SZR + (size_t)row * 512 + (pn - 9) * 256 + colw;
                        else dst = G + (size_t)row * 2048 + (pn - 11) * 256 + colw;
                        u32x4 w; w.x = cvt_pk_bf16(v0[0], v0[1]); w.y = cvt_pk_bf16(v0[2], v0[3]); w.z = cvt_pk_bf16(v1[0], v1[1]); w.w = cvt_pk_bf16(v1[2], v1[3]);
                        *(u32x4*)dst = w;
                    }
                }
        }
    }
};

template <int MODE> struct EpiMerge {
    static constexpr bool PERM = false, AFTER_DRAIN = false;
    bf16_t* O; const bf16_t* Gt; int ldo, ldg, goff;
    __device__ __forceinline__ void operator()(const f32x4 (&acc)[2][2][4][2], const Unit& u, int wr, int wc, int fr, int fq) const {
        const int row0 = u.pm * BM + wr * 64 + fr;
#pragma unroll
        for (int ai = 0; ai < 2; ++ai)
#pragma unroll
            for (int m = 0; m < 4; ++m) {
                const int row = row0 + ai * HALF + m * 16;
#pragma unroll
                for (int bj = 0; bj < 2; ++bj) {
                    const int col = u.pn * BM + 64 * wc + 32 * bj + 8 * fq;
                    f32x4 v0 = acc[ai][bj][m][0], v1 = acc[ai][bj][m][1];
                    bf16_t* dst = O + (size_t)row * ldo + col;
                    if (MODE != 2) {
                        const u32x4 g = *(const u32x4*)(Gt + (size_t)row * ldg + goff + col);
                        v0[0] *= bflo(g.x); v0[1] *= bfhi(g.x); v0[2] *= bflo(g.y); v0[3] *= bfhi(g.y); v1[0] *= bflo(g.z); v1[1] *= bfhi(g.z); v1[2] *= bflo(g.w); v1[3] *= bfhi(g.w);
                    }
                    if (MODE == 1) {
                        const u32x4 p = *(const u32x4*)dst;
                        v0[0] += bflo(p.x); v0[1] += bfhi(p.x); v0[2] += bflo(p.y); v0[3] += bfhi(p.y); v1[0] += bflo(p.z); v1[1] += bfhi(p.z); v1[2] += bflo(p.w); v1[3] += bfhi(p.w);
                    }
                    u32x4 w; w.x = cvt_pk_bf16(v0[0], v0[1]); w.y = cvt_pk_bf16(v0[2], v0[3]); w.z = cvt_pk_bf16(v1[0], v1[1]); w.w = cvt_pk_bf16(v1[2], v1[3]);
                    *(u32x4*)dst = w;
                }
            }
    }
};
}
namespace attn_body {
using bf16=__hip_bfloat16;
using bf16x8=__attribute__((ext_vector_type(8)))short;
using s16x4=__attribute__((ext_vector_type(4)))short;
using f32x16=__attribute__((ext_vector_type(16)))float;
using u32x4=__attribute__((ext_vector_type(4)))unsigned;
constexpr int BATCH=8,NHEAD=8,NKVH=2,SEQ=4096,D=64,DM=NHEAD*D,KVP=64;
constexpr int NW=8,QBLK=32,QB=QBLK*NW,KVBLK=64,NQB=SEQ/QB;
constexpr int ATTN_PITCH=DM, ATTN_UNIT_ROWS=QB;
__device__ __forceinline__ int crow(int r,int hi){return (r&3)+8*(r>>2)+4*hi;}
#define SBAR() __builtin_amdgcn_sched_barrier(0)
__device__ __forceinline__ void cmask(f32x16&p0,f32x16&p1,int jb,int qrel,int hi){
  const float NEG=-INFINITY; int kb=64*jb+4*hi;
  #pragma unroll
  for(int r=0;r<16;++r){int kv=kb+(r&3)+8*(r>>2); if(kv>qrel)p0[r]=NEG; if(kv+32>qrel)p1[r]=NEG;}
}

constexpr int NSLOT=3, SLOTB=8192;
constexpr int LDS_K=0, LDS_V=NSLOT*SLOTB, LDS_WS=2*NSLOT*SLOTB, LDS_OST=LDS_WS+NW*64*4, LDS_BYTES=LDS_OST+NW*4096;
constexpr float C2=0.125f*1.4426950408889634f;
__device__ __forceinline__ void glds16(const void*gsrc,unsigned lds_dst){unsigned keep;
  asm volatile("s_mov_b32 %0, m0\n\ts_mov_b32 m0, %2\n\ts_nop 0\n\tglobal_load_lds_dwordx4 %1, off\n\ts_mov_b32 m0, %0":"=&s"(keep):"v"(gsrc),"s"(lds_dst):"memory");}
__device__ __forceinline__ float max3f(float a,float b,float c){float r;asm("v_max3_f32 %0, %1, %2, %3":"=v"(r):"v"(a),"v"(b),"v"(c));return r;}
__device__ __forceinline__ float max2f(float a,float b){float r;asm("v_max_f32_e32 %0, %1, %2":"=v"(r):"v"(a),"v"(b));return r;}
__device__ __forceinline__ float fadd_s(float a,float b){float r;asm("v_add_f32_e32 %0, %1, %2":"=v"(r):"v"(a),"v"(b));return r;}
__device__ __forceinline__ float fsub_s(float a,float b){float r;asm("v_sub_f32_e32 %0, %1, %2":"=v"(r):"v"(a),"v"(b));return r;}
typedef float f32x2_t __attribute__((ext_vector_type(2))); typedef __bf16 bf16x2_t __attribute__((ext_vector_type(2)));
__device__ __forceinline__ unsigned cvtpk_s(float lo,float hi){f32x2_t v={lo,hi};bf16x2_t b=__builtin_convertvector(v,bf16x2_t);return __builtin_bit_cast(unsigned,b);}
#define WAIT_BAR(N) asm volatile("s_waitcnt vmcnt(" #N ") lgkmcnt(0)\n\ts_barrier":::"memory")

__device__ __forceinline__ void qkt(f32x16&p0,f32x16&p1,const char*Kslot,const bf16x8*qr,const f32x16&negm,int r32,int hi){
  const char*kb=Kslot+hi*1024+r32*16;
  #pragma unroll
  for(int d0=0;d0<4;++d0){
    const bf16x8 b0=*reinterpret_cast<const bf16x8*>(kb+d0*2048);
    const bf16x8 b1=*reinterpret_cast<const bf16x8*>(kb+d0*2048+512);
    if(d0==0){p0=__builtin_amdgcn_mfma_f32_32x32x16_bf16(b0,qr[0],negm,0,0,0);p1=__builtin_amdgcn_mfma_f32_32x32x16_bf16(b1,qr[0],negm,0,0,0);}
    else{p0=__builtin_amdgcn_mfma_f32_32x32x16_bf16(b0,qr[d0],p0,0,0,0);p1=__builtin_amdgcn_mfma_f32_32x32x16_bf16(b1,qr[d0],p1,0,0,0);}}
}
typedef __attribute__((address_space(3))) const char* lds_cptr;
typedef short v4i16_t __attribute__((ext_vector_type(4)));
__device__ __forceinline__ void kload8(bf16x8*kf,lds_cptr kp){
  kf[0]=*(const __attribute__((address_space(3))) bf16x8*)(kp);      kf[1]=*(const __attribute__((address_space(3))) bf16x8*)(kp+512);
  kf[2]=*(const __attribute__((address_space(3))) bf16x8*)(kp+2048); kf[3]=*(const __attribute__((address_space(3))) bf16x8*)(kp+2560);
  kf[4]=*(const __attribute__((address_space(3))) bf16x8*)(kp+4096); kf[5]=*(const __attribute__((address_space(3))) bf16x8*)(kp+4608);
  kf[6]=*(const __attribute__((address_space(3))) bf16x8*)(kp+6144); kf[7]=*(const __attribute__((address_space(3))) bf16x8*)(kp+6656);
}
__device__ __forceinline__ void kload2(bf16x8*kf,lds_cptr kp,int j){ kf[2*j]=*(const __attribute__((address_space(3))) bf16x8*)(kp+j*2048); kf[2*j+1]=*(const __attribute__((address_space(3))) bf16x8*)(kp+j*2048+512); }
__device__ __forceinline__ s16x4 vtr(lds_cptr p){ return __builtin_bit_cast(s16x4,__builtin_amdgcn_ds_read_tr16_b64_v4i16((__attribute__((address_space(3))) v4i16_t*)p)); }
__device__ __forceinline__ float rowmax(const f32x16&p0,const f32x16&p1){
  float a=max3f(p0[0],p0[1],p1[0]),b=max3f(p0[2],p0[3],p1[1]);a=max3f(a,p1[2],p1[3]);
  #pragma unroll
  for(int r=4;r<16;r+=4){a=max3f(a,p0[r],p0[r+1]);b=max3f(b,p0[r+2],p0[r+3]);a=max3f(a,p1[r],p1[r+1]);b=max3f(b,p1[r+2],p1[r+3]);}
  const float m=max2f(a,b);
  auto rr=__builtin_amdgcn_permlane32_swap(__float_as_uint(m),__float_as_uint(m),false,false);
  return max2f(__uint_as_float(rr[0]),__uint_as_float(rr[1]));
}
__device__ __forceinline__ void pv(f32x16*o,int vb,bf16x8 pa0,bf16x8 pa1,bf16x8 pa2,bf16x8 pa3){
  #pragma unroll
  for(int d0=0;d0<2;++d0){s16x4 lo[4],hi[4];
    #pragma unroll
    for(int ks=0;ks<4;++ks){
      asm volatile("ds_read_b64_tr_b16 %0,%1 offset:%c2":"=&v"(lo[ks]):"v"(vb),"i"(d0*4096+ks*1024):"memory");
      asm volatile("ds_read_b64_tr_b16 %0,%1 offset:%c2":"=&v"(hi[ks]):"v"(vb),"i"(d0*4096+ks*1024+512):"memory");}
    asm volatile("s_waitcnt lgkmcnt(0)":::"memory");SBAR();
    #define PK(k) (bf16x8){lo[k][0],lo[k][1],lo[k][2],lo[k][3],hi[k][0],hi[k][1],hi[k][2],hi[k][3]}
    o[d0]=__builtin_amdgcn_mfma_f32_32x32x16_bf16(pa0,PK(0),o[d0],0,0,0);
    o[d0]=__builtin_amdgcn_mfma_f32_32x32x16_bf16(pa1,PK(1),o[d0],0,0,0);
    o[d0]=__builtin_amdgcn_mfma_f32_32x32x16_bf16(pa2,PK(2),o[d0],0,0,0);
    o[d0]=__builtin_amdgcn_mfma_f32_32x32x16_bf16(pa3,PK(3),o[d0],0,0,0);
    #undef PK
  }
}

#ifndef ATTN_STORE16
#define ATTN_STORE16(p,v) (*(u32x4*)(p)=(v))
#endif
template<int THRL> __device__ __forceinline__ void attn_unit(int b,int h,int qb,const bf16*Q,const bf16*__restrict__ K,const bf16*__restrict__ V,const bf16*__restrict__ SZ,bf16*O,char*shm){
  const int tid=threadIdx.x,lane=tid&63,r32=lane&31,hi=lane>>5; const int wid=__builtin_amdgcn_readfirstlane(tid>>6);
  const long rowbase=(long)b*SEQ; const int q0=qb*QB;
  const bf16*Qw=Q+(rowbase+q0+wid*QBLK)*DM+h*D;
  const long kvbase=((long)b*NKVH+(h>>2))*SEQ*KVP; const bf16*Kh=K+kvbase,*Vh=V+kvbase;
  const unsigned lds0=(unsigned)(uintptr_t)shm;
  float*wsf=(float*)(shm+LDS_WS)+wid*64;
  const bf16*ksrc=Kh+(long)lane*KVP+wid*8;
  const bf16*vsrc=Vh+(long)(16*(wid&3)+(lane>>2))*KVP+(wid>>2)*32+(lane&3)*8;
  const unsigned kdst=lds0+LDS_K+wid*1024, vdst=lds0+LDS_V+wid*1024;
  #define DMA_K(t,slot) glds16(ksrc+(long)(t)*KVBLK*KVP,(unsigned)__builtin_amdgcn_readfirstlane(kdst+(slot)))
  #define DMA_V(t,slot) glds16(vsrc+(long)(t)*KVBLK*KVP,(unsigned)__builtin_amdgcn_readfirstlane(vdst+(slot)))
  const int vb0=(int)(lds0+LDS_V)+((lane>>4)&1)*32+(lane&3)*8+(4*hi+((lane&15)>>2))*64;
  const char*Kbase=shm+LDS_K; bf16x8 kf[8];
  const lds_cptr shm3=(lds_cptr)shm; const lds_cptr kp0=shm3+LDS_K+hi*1024+r32*16; const lds_cptr vp0=shm3+LDS_V+((lane>>4)&1)*32+(lane&3)*8+(4*hi+((lane&15)>>2))*64;
  constexpr int NT=SEQ/KVBLK;
  DMA_K(0,0);DMA_V(0,0);DMA_K(1,SLOTB);
  bf16x8 qr[4];
  #pragma unroll
  for(int d0=0;d0<4;++d0)qr[d0]=*reinterpret_cast<const bf16x8*>(&Qw[(long)r32*DM+d0*16+hi*8]);
  float mhat=0.f,l_reg=0.f;f32x16 o[2];o[0]=f32x16{};o[1]=f32x16{};f32x16 negm=f32x16{};asm volatile("":"+v"(negm));
    #define CMASK(P0,P1,t) do{}while(0)
  bool resc=false;
  #define START(P0,P1) do{ const float rm=rowmax(P0,P1); resc=false; \
    { const float dl=rm; mhat=fadd_s(mhat,dl); \
      _Pragma("unroll") for(int r=0;r<16;++r){P0[r]=fsub_s(P0[r],dl);P1[r]=fsub_s(P1[r],dl);} \
      _Pragma("unroll") for(int r=0;r<16;++r)negm[r]=-mhat; asm volatile("":"+v"(negm)); } \
    _Pragma("unroll") for(int r=0;r<16;++r)P0[r]=__builtin_amdgcn_exp2f(P0[r]); }while(0)
  #define RESC() do{ if(resc){ asm volatile("s_waitcnt lgkmcnt(0)":::"memory"); \
      _Pragma("unroll") for(int d_=0;d_<2;++d_) _Pragma("unroll") for(int r=0;r<16;++r)o[d_][r]*=wsf[crow(r,hi)]; } }while(0)
  f32x16 pA0,pA1,pB0,pB1;
  int sl_prev=0,sl_cur=0,sl_next=SLOTB;
  #define ROT() do{sl_prev=sl_cur;sl_cur=sl_next;sl_next=(sl_next==(NSLOT-1)*SLOTB)?0:sl_next+SLOTB;}while(0)
  DMA_K(2,2*SLOTB);
  WAIT_BAR(3);
  qkt(pA0,pA1,Kbase,qr,negm,r32,hi);asm volatile("s_nop 15\n\ts_nop 7":"+v"(pA0),"+v"(pA1));CMASK(pA0,pA1,0);
  START(pA0,pA1);
  _Pragma("unroll") for(int r=0;r<16;++r)pA1[r]=__builtin_amdgcn_exp2f(pA1[r]);
  WAIT_BAR(0);
  DMA_K(3,0);DMA_V(1,SLOTB);
  ROT();
  kload8(kf,kp0+sl_cur);
  WAIT_BAR(2);
  s16x4 vlo[8],vhi[8]; u32x4 pw0,pw1,pw2,pw3;
  #define PKW(P,B) cvtpk_s(P[B],P[B+1])
  #define PAF(k) __builtin_bit_cast(bf16x8,pw##k)
  #define VFR(i) (bf16x8){vlo[i][0],vlo[i][1],vlo[i][2],vlo[i][3],vhi[i][0],vhi[i][1],vhi[i][2],vhi[i][3]}
  #define PIN(x) asm volatile("":"+v"(x))
  #define MX3(a,b,c) __builtin_fmaxf(__builtin_fmaxf((a),(b)),(c))
  #define GAPA(MF,A0,A1,A2,A3,W0,W1,PW) do{ MF; sacc+=A0; sacc+=A1; sacc+=A2; sacc+=A3; PIN(sacc); W0; W1; PIN(PW); SBAR(); }while(0)
  #define EX(v) __builtin_amdgcn_exp2f(v)
  #define GAPB(MF,X,B) do{ MF; X[B]=EX(X[B]); X[B+1]=EX(X[B+1]); X[B+2]=EX(X[B+2]); X[B+3]=EX(X[B+3]); PIN(X); SBAR(); }while(0)
  #define VRD(i) do{ vlo[i]=vtr(vp_+(((i)>>2)*4096+((i)&3)*1024)); vhi[i]=vtr(vp_+(((i)>>2)*4096+((i)&3)*1024+512)); }while(0)
  #define KRD(G,j) do{ if(G){ kload2(kf,kp0+sl_next,j); SBAR(); } }while(0)
  #define STEP(C0,C1,P0,P1,t,GK,GV,GL) do{ SBAR(); \
    const lds_cptr vp_=vp0+sl_prev; \
    VRD(0); SBAR(); float sacc=(P0[0]+P0[1]); \
    GAPA(C0=__builtin_amdgcn_mfma_f32_32x32x16_bf16(kf[0],qr[0],negm,0,0,0), P0[2],P0[3],P0[4],P0[5],     pw0[0]=PKW(P0,0), pw0[1]=PKW(P0,2), pw0); \
    VRD(4); SBAR(); GAPA(C1=__builtin_amdgcn_mfma_f32_32x32x16_bf16(kf[1],qr[0],negm,0,0,0), P0[6],P0[7],P0[8],P0[9],     pw0[2]=PKW(P0,4), pw0[3]=PKW(P0,6), pw0); \
    VRD(1); SBAR(); GAPA(C0=__builtin_amdgcn_mfma_f32_32x32x16_bf16(kf[2],qr[1],C0,0,0,0),   P0[10],P0[11],P0[12],P0[13], pw1[0]=PKW(P0,8), pw1[1]=PKW(P0,10), pw1); \
    VRD(5); SBAR(); GAPA(C1=__builtin_amdgcn_mfma_f32_32x32x16_bf16(kf[3],qr[1],C1,0,0,0),   P0[14],P0[15],P1[0],P1[1],   pw1[2]=PKW(P0,12),pw1[3]=PKW(P0,14), pw1); \
    VRD(2); SBAR(); GAPA(C0=__builtin_amdgcn_mfma_f32_32x32x16_bf16(kf[4],qr[2],C0,0,0,0),   P1[2],P1[3],P1[4],P1[5],     pw2[0]=PKW(P1,0), pw2[1]=PKW(P1,2), pw2); \
    VRD(6); SBAR(); GAPA(C1=__builtin_amdgcn_mfma_f32_32x32x16_bf16(kf[5],qr[2],C1,0,0,0),   P1[6],P1[7],P1[8],P1[9],     pw2[2]=PKW(P1,4), pw2[3]=PKW(P1,6), pw2); \
    VRD(3); SBAR(); GAPA(C0=__builtin_amdgcn_mfma_f32_32x32x16_bf16(kf[6],qr[3],C0,0,0,0),   P1[10],P1[11],P1[12],P1[13], pw3[0]=PKW(P1,8), pw3[1]=PKW(P1,10), pw3); \
    VRD(7); SBAR(); GAPA(C1=__builtin_amdgcn_mfma_f32_32x32x16_bf16(kf[7],qr[3],C1,0,0,0),   P1[14],P1[15],0.f,0.f,       pw3[2]=PKW(P1,12),pw3[3]=PKW(P1,14), pw3); \
    l_reg+=sacc; \
    if(GK){DMA_K((t)+3,sl_cur);} if(GV){DMA_V((t)+1,sl_next);} \
    CMASK(C0,C1,t); \
    { float a=MX3(C0[0],C0[1],C1[0]),b=MX3(C0[2],C0[3],C1[1]); a=MX3(a,C1[2],C1[3]); \
      _Pragma("unroll") for(int r=4;r<16;r+=4){a=MX3(a,C0[r],C0[r+1]);b=MX3(b,C0[r+2],C0[r+3]);a=MX3(a,C1[r],C1[r+1]);b=MX3(b,C1[r+2],C1[r+3]);} \
      float rm=__builtin_fmaxf(a,b); { auto rr=__builtin_amdgcn_permlane32_swap(__float_as_uint(rm),__float_as_uint(rm),false,false); rm=__builtin_fmaxf(__uint_as_float(rr[0]),__uint_as_float(rr[1])); } \
      resc=false; \
      if(__builtin_expect(__any(rm>(float)THRL),0)){ const float dl=__builtin_fmaxf(rm,0.f); mhat+=dl; \
        _Pragma("unroll") for(int r=0;r<16;++r){C0[r]-=dl;C1[r]-=dl;} \
        _Pragma("unroll") for(int r=0;r<16;++r)negm[r]=-mhat; asm volatile("":"+v"(negm)); \
        const float f=__builtin_amdgcn_exp2f(-dl); l_reg*=f; if(hi==0)wsf[r32]=f; resc=true; } } \
    SBAR(); \
    GAPB(o[0]=__builtin_amdgcn_mfma_f32_32x32x16_bf16(PAF(0),VFR(0),o[0],0,0,0), C0,0); \
    GAPB(o[1]=__builtin_amdgcn_mfma_f32_32x32x16_bf16(PAF(0),VFR(4),o[1],0,0,0), C0,4); \
    KRD(GL,0); GAPB(o[0]=__builtin_amdgcn_mfma_f32_32x32x16_bf16(PAF(1),VFR(1),o[0],0,0,0), C0,8); \
    KRD(GL,1); GAPB(o[1]=__builtin_amdgcn_mfma_f32_32x32x16_bf16(PAF(1),VFR(5),o[1],0,0,0), C0,12); \
    KRD(GL,2); GAPB(o[0]=__builtin_amdgcn_mfma_f32_32x32x16_bf16(PAF(2),VFR(2),o[0],0,0,0), C1,0); \
    KRD(GL,3); GAPB(o[1]=__builtin_amdgcn_mfma_f32_32x32x16_bf16(PAF(2),VFR(6),o[1],0,0,0), C1,4); \
    GAPB(o[0]=__builtin_amdgcn_mfma_f32_32x32x16_bf16(PAF(3),VFR(3),o[0],0,0,0), C1,8); \
    GAPB(o[1]=__builtin_amdgcn_mfma_f32_32x32x16_bf16(PAF(3),VFR(7),o[1],0,0,0), C1,12); \
    }while(0)
  int t=1;
  #undef CMASK
  #define CMASK(P0,P1,t) do{}while(0)
  for(;t+5<NT;t+=2){
    STEP(pB0,pB1,pA0,pA1,t,true,true,true);     WAIT_BAR(2); RESC(); ROT();
    STEP(pA0,pA1,pB0,pB1,t+1,true,true,true);   WAIT_BAR(2); RESC(); ROT();
  }
  #undef CMASK
  #define CMASK(P0,P1,t) do{}while(0)
  #define ENDW(tt) do{ if((tt)+3<NT){WAIT_BAR(2);} else if((tt)+2<NT){WAIT_BAR(1);} else {WAIT_BAR(0);} }while(0)
  for(;t+1<NT;t+=2){
    STEP(pB0,pB1,pA0,pA1,t,(t+3<NT),(t+1<NT),(t+1<NT));       ENDW(t);   RESC(); ROT();
    STEP(pA0,pA1,pB0,pB1,t+1,(t+4<NT),(t+2<NT),(t+2<NT));     ENDW(t+1); RESC(); ROT();
  }
  STEP(pB0,pB1,pA0,pA1,NT-1,false,false,false); RESC();
  { float sacc=pB0[0]+pB0[1]; _Pragma("unroll") for(int r=2;r<16;++r)sacc+=pB0[r]; _Pragma("unroll") for(int r=0;r<16;++r)sacc+=pB1[r]; l_reg+=sacc;
    pw0=(u32x4){PKW(pB0,0),PKW(pB0,2),PKW(pB0,4),PKW(pB0,6)};pw1=(u32x4){PKW(pB0,8),PKW(pB0,10),PKW(pB0,12),PKW(pB0,14)};pw2=(u32x4){PKW(pB1,0),PKW(pB1,2),PKW(pB1,4),PKW(pB1,6)};pw3=(u32x4){PKW(pB1,8),PKW(pB1,10),PKW(pB1,12),PKW(pB1,14)};
    SBAR(); pv(o,vb0+sl_cur,PAF(0),PAF(1),PAF(2),PAF(3)); }
  #undef PKW
  #undef PAF
  #undef VFR
  #undef PIN
  #undef MX3
  #undef GAPA
  #undef GAPB
  #undef EX
  #undef VRD
  #undef KRD
  #undef STEP
  #undef ENDW
  {auto rr=__builtin_amdgcn_permlane32_swap(__float_as_uint(l_reg),__float_as_uint(l_reg),false,false);l_reg=__uint_as_float(rr[0])+__uint_as_float(rr[1]);}
  if(hi==0)wsf[32+r32]=l_reg;asm volatile("s_waitcnt lgkmcnt(0)":::"memory");
  float rli[16];
  #pragma unroll
  for(int r=0;r<16;++r)rli[r]=__builtin_amdgcn_rcpf(wsf[32+crow(r,hi)]);
  bf16*Ow=O+(rowbase+q0+wid*QBLK)*DM+h*D; const bf16*SZw=SZ+(rowbase+q0+wid*QBLK)*DM+h*D;
  { bf16*stg=(bf16*)(shm+LDS_OST)+wid*2048;
    #pragma unroll
    for(int r=0;r<16;++r){const int orow=crow(r,hi);
      #pragma unroll
      for(int d0=0;d0<2;++d0)stg[orow*64+d0*32+r32]=__float2bfloat16(o[d0][r]*rli[r]);}
    asm volatile("s_waitcnt lgkmcnt(0)":::"memory");
    #pragma unroll
    for(int i=0;i<4;++i){const int row=i*8+(lane>>3),ch=lane&7; const u32x4 v=*(const u32x4*)(stg+row*64+ch*8); const u32x4 g=*(const u32x4*)(SZw+(long)row*DM+ch*8); u32x4 w;
      #pragma unroll
      for(int k=0;k<4;++k){ const float a0=__uint_as_float(v[k]<<16),a1=__uint_as_float(v[k]&0xffff0000u),g0=__uint_as_float(g[k]<<16),g1=__uint_as_float(g[k]&0xffff0000u); w[k]=cvtpk_s(a0*g0,a1*g1); }
      ATTN_STORE16(Ow+(long)row*DM+ch*8,w);} }
  asm volatile("s_waitcnt lgkmcnt(0)\n\ts_barrier":::"memory");
  #undef DMA_K
  #undef DMA_V
  #undef CMASK
  #undef START
  #undef RESC
  #undef ROT
}
constexpr int ATTN_LDS_BYTES=LDS_BYTES;
struct AttnTensors { const bf16* Q; const bf16* K; const bf16* V; const bf16* SZ; bf16* O; };
struct AttnUnit { int bh; int qb; };
struct StaticOrder {
  int vcu, G;
  __device__ __forceinline__ explicit StaticOrder(int grid,int block):vcu((grid%8==0)?((block%8)*(grid/8)+block/8):block),G(grid){}
  __device__ __forceinline__ bool next(int i,AttnUnit&u)const{ const int L=i*G+vcu; if(L>=BATCH*NHEAD*NQB)return false; const int w=L&255, hg=L>>8, grp=w>>4; u.bh=(grp>>1)*NHEAD+(grp&1)*4+hg; u.qb=w&15; return true; }
  __device__ __forceinline__ void a_ready(const AttnUnit&)const{}
  __device__ __forceinline__ void done(const AttnUnit&)const{}
};
template<class Sched,int THRL=8> __device__ __forceinline__ void attn_phase(char*lds,const AttnTensors&T,const Sched&S){
  AttnUnit u;
  for(int i=0;S.next(i,u);++i){ S.a_ready(u); attn_unit<THRL>(u.bh/NHEAD,u.bh%NHEAD,u.qb,T.Q,T.K,T.V,T.SZ,T.O,lds); S.done(u); }
}
#undef SBAR
#undef WAIT_BAR
}
namespace ret {
#define RLAS __attribute__((address_space(3)))
typedef short bf16x8 __attribute__((ext_vector_type(8)));
typedef short s16x4 __attribute__((ext_vector_type(4)));
typedef short v4i16_t __attribute__((ext_vector_type(4)));
typedef float f32x16 __attribute__((ext_vector_type(16)));
typedef float f32x4 __attribute__((ext_vector_type(4)));
typedef float f32x2 __attribute__((ext_vector_type(2)));
typedef unsigned u32x4 __attribute__((ext_vector_type(4)));
typedef unsigned u32x2 __attribute__((ext_vector_type(2)));
typedef unsigned short bf16_t;
constexpr int SEQ = 4096, NH = 4, NSEG = 8;
constexpr int QP = 144, VP = 320;
constexpr int L_Q = 0, L_K = 18432, L_V = 36864, L_RF = 77824, L_RB = 96256, L_STAT = 114688, L_END = 116736;
constexpr int ST_ELEMS = 128 * 64;
__device__ __forceinline__ int crow(int r, int hi) { return (r & 3) + 8 * (r >> 2) + 4 * hi; }
__device__ __forceinline__ s16x4 vtr(RLAS const char* p) { return __builtin_bit_cast(s16x4, __builtin_amdgcn_ds_read_tr16_b64_v4i16((RLAS v4i16_t*)p)); }
__device__ __forceinline__ unsigned cvtpk(float lo, float hi) { typedef float f2 __attribute__((ext_vector_type(2))); typedef __bf16 b2 __attribute__((ext_vector_type(2))); f2 v = {lo, hi}; b2 b = __builtin_convertvector(v, b2); return __builtin_bit_cast(unsigned, b); }
__device__ __forceinline__ float bf2f(short x) { return __uint_as_float(((unsigned)(unsigned short)x) << 16); }
__device__ __forceinline__ float ex2(float x) { return __builtin_amdgcn_exp2f(x); }
#define RMFMA(a, b, c) __builtin_amdgcn_mfma_f32_32x32x16_bf16(a, b, c, 0, 0, 0)

__device__ __forceinline__ void stage_qk(const bf16_t* g, RLAS char* dst, int tid) {
    const int row = tid >> 2, q = tid & 3;
    const u32x4* src = (const u32x4*)(g + row * 64 + q * 16);
    const u32x4 a = src[0], b = src[1];
    *(RLAS u32x4*)(dst + row * QP + q * 32) = a; *(RLAS u32x4*)(dst + row * QP + q * 32 + 16) = b;
}
__device__ __forceinline__ void stage_v(const bf16_t* g, RLAS char* dst, int tid) {
    const int row = tid >> 2, q = tid & 3;
    const u32x4* src = (const u32x4*)(g + row * 128 + q * 32);
    u32x4 a[4];
#pragma unroll
    for (int j = 0; j < 4; ++j) a[j] = src[j];
#pragma unroll
    for (int j = 0; j < 4; ++j) *(RLAS u32x4*)(dst + row * VP + q * 64 + j * 16) = a[j];
}

template <bool FWD> __device__ __forceinline__ void state_chunk(f32x16& acc, RLAS const char* lds, float lg2, int eb, int db, int lane) {
    const int hh = lane >> 5;
    asm volatile("" : "+v"(lg2));
    const float cd = ex2(lg2 * 128.0f);
#pragma unroll
    for (int i = 0; i < 16; ++i) acc[i] *= cd;
    const int trrow = 4 * hh + ((lane & 15) >> 2), csub = 16 * ((lane >> 4) & 1) + 4 * (lane & 3);
    RLAS const char* vp = lds + L_V + trrow * VP + (32 * eb + csub) * 2;
    RLAS const char* kp = lds + L_K + trrow * QP + (32 * db + csub) * 2;
#pragma unroll
    for (int ks = 0; ks < 8; ++ks) {
        const int t0 = 16 * ks;
        const s16x4 alo = vtr(vp + t0 * VP), ahi = vtr(vp + (t0 + 8) * VP);
        const s16x4 blo = vtr(kp + t0 * QP), bhi = vtr(kp + (t0 + 8) * QP);
        float wl[4], wh[4];
#pragma unroll
        for (int j = 0; j < 4; ++j) { const int tl = t0 + 4 * hh + j, th = tl + 8; wl[j] = ex2(lg2 * (float)(FWD ? 127 - tl : tl)); wh[j] = ex2(lg2 * (float)(FWD ? 127 - th : th)); }
        u32x4 bw;
        bw.x = cvtpk(bf2f(blo[0]) * wl[0], bf2f(blo[1]) * wl[1]); bw.y = cvtpk(bf2f(blo[2]) * wl[2], bf2f(blo[3]) * wl[3]);
        bw.z = cvtpk(bf2f(bhi[0]) * wh[0], bf2f(bhi[1]) * wh[1]); bw.w = cvtpk(bf2f(bhi[2]) * wh[2], bf2f(bhi[3]) * wh[3]);
        const bf16x8 A = (bf16x8){alo[0], alo[1], alo[2], alo[3], ahi[0], ahi[1], ahi[2], ahi[3]};
        acc = RMFMA(A, __builtin_bit_cast(bf16x8, bw), acc);
    }
}
__device__ __forceinline__ void store_state(const f32x16& acc, float* dst, int eb, int db, int lane) {
    const int r = lane & 31, hh = lane >> 5;
#pragma unroll
    for (int i = 0; i < 16; ++i) dst[(32 * eb + crow(i, hh)) * 64 + 32 * db + r] = acc[i];
}

__device__ __forceinline__ void pass1_item(int item, const bf16_t* RK, const bf16_t* RV, float* ST, float lg2f, float lg2b, RLAS char* lds) {
    const int tid = threadIdx.x, lane = tid & 63, wid = __builtin_amdgcn_readfirstlane(tid >> 6), eb = wid >> 1, db = wid & 1;
    const int bh = item >> 3, g = item & 7;
    const size_t tok0 = (size_t)bh * SEQ + (size_t)g * 512;
    float* st = ST + (size_t)item * 8 * ST_ELEMS;
    f32x16 accF = f32x16{}, accB = f32x16{};
    for (int step = 0; step < 4; ++step) {
        {   const int c = step;
            __syncthreads();
            stage_qk(RK + (tok0 + c * 128) * 64, lds + L_K, tid); stage_v(RV + (tok0 + c * 128) * 128, lds + L_V, tid);
            __syncthreads();
            state_chunk<true>(accF, lds, lg2f, eb, db, lane);
            store_state(accF, st + (size_t)c * ST_ELEMS, eb, db, lane); }
        {   const int c = 3 - step;
            __syncthreads();
            stage_qk(RK + (tok0 + c * 128) * 64, lds + L_K, tid); stage_v(RV + (tok0 + c * 128) * 128, lds + L_V, tid);
            __syncthreads();
            state_chunk<false>(accB, lds, lg2b, eb, db, lane);
            store_state(accB, st + (size_t)(c >= 1 ? 4 + (c - 1) : 7) * ST_ELEMS, eb, db, lane); }
    }
}

__device__ __forceinline__ void pass2_item(int item, const bf16_t* RQ, const bf16_t* RK, const bf16_t* RV, const bf16_t* SZR, const float* ST, const float* gn_g,
                                           float lg2f, float lg2b, bf16_t* YR, RLAS char* lds) {
    const int tid = threadIdx.x, lane = tid & 63, wid = __builtin_amdgcn_readfirstlane(tid >> 6), r = lane & 31, hh = lane >> 5, ib = wid >> 1, eh = wid & 1;
    const int bh = item >> 3, g = item & 7, b = bh >> 2, h = bh & 3;
    const size_t tok0 = (size_t)bh * SEQ + (size_t)g * 512;
    const size_t trow0 = (size_t)b * SEQ + (size_t)g * 512;
    const int pe = tid >> 2, pdq = tid & 3;
    f32x4 rinF[4], rinB[4];
#pragma unroll
    for (int k = 0; k < 4; ++k) { rinF[k] = (f32x4){0.f, 0.f, 0.f, 0.f}; rinB[k] = (f32x4){0.f, 0.f, 0.f, 0.f}; }
    for (int gp = 0; gp < g; ++gp) {
        const float w = ex2(lg2f * 512.0f * (float)(g - 1 - gp));
        const f32x4* src = (const f32x4*)(ST + ((size_t)(bh * 8 + gp) * 8 + 3) * ST_ELEMS + pe * 64 + pdq * 16);
#pragma unroll
        for (int k = 0; k < 4; ++k) rinF[k] += src[k] * w;
    }
    for (int gp = g + 1; gp < NSEG; ++gp) {
        const float w = ex2(lg2b * 512.0f * (float)(gp - g - 1));
        const f32x4* src = (const f32x4*)(ST + ((size_t)(bh * 8 + gp) * 8 + 7) * ST_ELEMS + pe * 64 + pdq * 16);
#pragma unroll
        for (int k = 0; k < 4; ++k) rinB[k] += src[k] * w;
    }
    const int och = lane & 7;
    const f32x4 gn0 = *(const f32x4*)(gn_g + h * 128 + 64 * eh + 8 * och), gn1 = *(const f32x4*)(gn_g + h * 128 + 64 * eh + 8 * och + 4);
    const float* stI = ST + (size_t)item * 8 * ST_ELEMS + pe * 64 + pdq * 16;
    for (int c = 0; c < 4; ++c) {
        __syncthreads();
        stage_qk(RQ + (tok0 + c * 128) * 64, lds + L_Q, tid); stage_qk(RK + (tok0 + c * 128) * 64, lds + L_K, tid); stage_v(RV + (tok0 + c * 128) * 128, lds + L_V, tid);
        {   const float wf = ex2(lg2f * 128.0f * (float)c), wb = ex2(lg2b * 128.0f * (float)(3 - c));
            f32x4 vf[4], vb[4];
#pragma unroll
            for (int k = 0; k < 4; ++k) { vf[k] = rinF[k] * wf; vb[k] = rinB[k] * wb; }
            if (c > 0) { const f32x4* s = (const f32x4*)(stI + (size_t)(c - 1) * ST_ELEMS);
#pragma unroll
                for (int k = 0; k < 4; ++k) vf[k] += s[k]; }
            if (c < 3) { const f32x4* s = (const f32x4*)(stI + (size_t)(4 + c) * ST_ELEMS);
#pragma unroll
                for (int k = 0; k < 4; ++k) vb[k] += s[k]; }
            u32x4 a, bq;
            a.x = cvtpk(vf[0][0], vf[0][1]); a.y = cvtpk(vf[0][2], vf[0][3]); a.z = cvtpk(vf[1][0], vf[1][1]); a.w = cvtpk(vf[1][2], vf[1][3]);
            bq.x = cvtpk(vf[2][0], vf[2][1]); bq.y = cvtpk(vf[2][2], vf[2][3]); bq.z = cvtpk(vf[3][0], vf[3][1]); bq.w = cvtpk(vf[3][2], vf[3][3]);
            *(RLAS u32x4*)(lds + L_RF + pe * QP + pdq * 32) = a; *(RLAS u32x4*)(lds + L_RF + pe * QP + pdq * 32 + 16) = bq;
            a.x = cvtpk(vb[0][0], vb[0][1]); a.y = cvtpk(vb[0][2], vb[0][3]); a.z = cvtpk(vb[1][0], vb[1][1]); a.w = cvtpk(vb[1][2], vb[1][3]);
            bq.x = cvtpk(vb[2][0], vb[2][1]); bq.y = cvtpk(vb[2][2], vb[2][3]); bq.z = cvtpk(vb[3][0], vb[3][1]); bq.w = cvtpk(vb[3][2], vb[3][3]);
            *(RLAS u32x4*)(lds + L_RB + pe * QP + pdq * 32) = a; *(RLAS u32x4*)(lds + L_RB + pe * QP + pdq * 32 + 16) = bq; }
        __syncthreads();
        int il = 32 * ib + r;
        asm volatile("" : "+v"(il));
        bf16x8 qf[4];
#pragma unroll
        for (int s = 0; s < 4; ++s) qf[s] = *(RLAS const bf16x8*)(lds + L_Q + il * QP + (16 * s + 8 * hh) * 2);
        f32x16 ot[2]; ot[0] = f32x16{}; ot[1] = f32x16{};
        RLAS const char* vbase = lds + L_V + (4 * hh + ((lane & 15) >> 2)) * VP + (64 * eh + 16 * ((lane >> 4) & 1) + 4 * (lane & 3)) * 2;
#pragma unroll
        for (int jb = 0; jb < 4; ++jb) {
            f32x16 st = f32x16{};
#pragma unroll
            for (int s = 0; s < 4; ++s) { const bf16x8 kf = *(RLAS const bf16x8*)(lds + L_K + (32 * jb + r) * QP + (16 * s + 8 * hh) * 2); st = RMFMA(kf, qf[s], st); }
#pragma unroll
            for (int i = 0; i < 16; ++i) { const int d = il - (32 * jb + crow(i, hh)); const float ex = d >= 0 ? lg2f * (float)d : lg2b * (float)(-d); st[i] *= ex2(ex); }
            u32x4 p0, p1;
            p0.x = cvtpk(st[0], st[1]); p0.y = cvtpk(st[2], st[3]); p0.z = cvtpk(st[4], st[5]); p0.w = cvtpk(st[6], st[7]);
            p1.x = cvtpk(st[8], st[9]); p1.y = cvtpk(st[10], st[11]); p1.z = cvtpk(st[12], st[13]); p1.w = cvtpk(st[14], st[15]);
#pragma unroll
            for (int k = 0; k < 2; ++k)
#pragma unroll
                for (int s2 = 0; s2 < 2; ++s2) {
                    const int t0 = 32 * jb + 16 * s2;
                    const s16x4 alo = vtr(vbase + t0 * VP + k * 64), ahi = vtr(vbase + (t0 + 8) * VP + k * 64);
                    const bf16x8 A = (bf16x8){alo[0], alo[1], alo[2], alo[3], ahi[0], ahi[1], ahi[2], ahi[3]};
                    ot[k] = RMFMA(A, __builtin_bit_cast(bf16x8, s2 ? p1 : p0), ot[k]);
                }
        }
        {   const float qdf = ex2(lg2f * (float)(il + 1)), qdb = ex2(lg2b * (float)(128 - il));
#pragma unroll
            for (int k = 0; k < 2; ++k) {
                f32x16 tf = f32x16{}, tb = f32x16{};
                const int erow = 64 * eh + 32 * k + r;
#pragma unroll
                for (int s = 0; s < 4; ++s) {
                    const bf16x8 rf = *(RLAS const bf16x8*)(lds + L_RF + erow * QP + (16 * s + 8 * hh) * 2);
                    const bf16x8 rb = *(RLAS const bf16x8*)(lds + L_RB + erow * QP + (16 * s + 8 * hh) * 2);
                    tf = RMFMA(rf, qf[s], tf); tb = RMFMA(rb, qf[s], tb);
                }
#pragma unroll
                for (int i = 0; i < 16; ++i) ot[k][i] += qdf * tf[i] + qdb * tb[i];
            } }
        float s1 = 0.f, s2 = 0.f;
#pragma unroll
        for (int k = 0; k < 2; ++k)
#pragma unroll
            for (int i = 0; i < 16; ++i) { const float v = ot[k][i]; s1 += v; s2 += v * v; }
        s1 += __shfl_xor(s1, 32); s2 += __shfl_xor(s2, 32);
        RLAS f32x2* stat = (RLAS f32x2*)(lds + L_STAT);
        if (hh == 0) stat[(ib * 2 + eh) * 32 + r] = (f32x2){s1, s2};
        __syncthreads();
        {   const f32x2 o = stat[(ib * 2 + (eh ^ 1)) * 32 + r]; s1 += o.x; s2 += o.y; }
        const float mu = s1 * (1.0f / 128.0f), var = fmaxf(s2 * (1.0f / 128.0f) - mu * mu, 0.f), rstd = __builtin_amdgcn_rsqf(var + 1e-6f);
        RLAS char* stg = lds + L_V + wid * 4608;
#pragma unroll
        for (int k = 0; k < 2; ++k)
#pragma unroll
            for (int q = 0; q < 4; ++q) {
                u32x2 w; w.x = cvtpk((ot[k][4 * q] - mu) * rstd, (ot[k][4 * q + 1] - mu) * rstd); w.y = cvtpk((ot[k][4 * q + 2] - mu) * rstd, (ot[k][4 * q + 3] - mu) * rstd);
                *(RLAS u32x2*)(stg + r * 144 + 64 * k + 16 * q + 8 * hh) = w;
            }
#pragma unroll
        for (int it = 0; it < 4; ++it) {
            const int row = it * 8 + (lane >> 3);
            const u32x4 y = *(RLAS const u32x4*)(stg + row * 144 + och * 16);
            const size_t off = (trow0 + c * 128 + 32 * ib + row) * 512 + h * 128 + 64 * eh + 8 * och;
            const u32x4 z = *(const u32x4*)(SZR + off);
            u32x4 w;
            w.x = cvtpk(__uint_as_float(y.x << 16) * gn0[0] * __uint_as_float(z.x << 16), __uint_as_float(y.x & 0xffff0000u) * gn0[1] * __uint_as_float(z.x & 0xffff0000u));
            w.y = cvtpk(__uint_as_float(y.y << 16) * gn0[2] * __uint_as_float(z.y << 16), __uint_as_float(y.y & 0xffff0000u) * gn0[3] * __uint_as_float(z.y & 0xffff0000u));
            w.z = cvtpk(__uint_as_float(y.z << 16) * gn1[0] * __uint_as_float(z.z << 16), __uint_as_float(y.z & 0xffff0000u) * gn1[1] * __uint_as_float(z.z & 0xffff0000u));
            w.w = cvtpk(__uint_as_float(y.w << 16) * gn1[2] * __uint_as_float(z.w << 16), __uint_as_float(y.w & 0xffff0000u) * gn1[3] * __uint_as_float(z.w & 0xffff0000u));
            *(u32x4*)(YR + off) = w;
        }
    }
}
}
#define GAS __attribute__((address_space(1)))
#define LAS __attribute__((address_space(3)))
typedef unsigned short bf16;
typedef unsigned v4u __attribute__((ext_vector_type(4)));
typedef float f32x4 __attribute__((ext_vector_type(4)));
typedef short bf16x8 __attribute__((ext_vector_type(8)));
typedef GAS unsigned gu32;
typedef GAS unsigned long long gu64;
#define RLX_AGENT __ATOMIC_RELAXED, __HIP_MEMORY_SCOPE_AGENT
#define LDS_WAIT() asm volatile("s_waitcnt lgkmcnt(0)" ::: "memory")
#define VM_WAIT() asm volatile("s_waitcnt vmcnt(0)" ::: "memory")
__device__ __forceinline__ unsigned long long rt() { return __builtin_amdgcn_s_memrealtime(); }
__device__ __forceinline__ unsigned f2bf(float f) { unsigned u = __builtin_bit_cast(unsigned, f); return (u + 0x7fffu + ((u >> 16) & 1u)) >> 16; }
__device__ __forceinline__ unsigned pk2(float lo, float hi) { return f2bf(lo) | (f2bf(hi) << 16); }

#define XB_TMO      128
#define XB_XCNT(j)  (256  + 64 * (j))
#define XB_XSUB(j)  (1280 + 64 * (j))
#define XB_XGEN(j)  (2304 + 64 * (j))
#define XB_TOP      3328
#define XB_TOPGEN   3392
#define XCD_BAR_WORDS 3456
#define XB_SPIN_CAP (1u << 18)

__device__ __forceinline__ unsigned xb_ld(unsigned* p)              { return __hip_atomic_load(p, __ATOMIC_RELAXED, __HIP_MEMORY_SCOPE_AGENT); }
__device__ __forceinline__ unsigned xb_add(unsigned* p, unsigned v) { return __hip_atomic_fetch_add(p, v, __ATOMIC_RELAXED, __HIP_MEMORY_SCOPE_AGENT); }
__device__ __forceinline__ unsigned xb_xcc_id() { return (unsigned)__builtin_amdgcn_s_getreg((3 << 11) | 20) & 0xFu; }
#define XB_SPIN(cond, bar) do { unsigned _sp = 0; while (cond) { __builtin_amdgcn_s_sleep(1); \
    if ((++_sp & 255u) == 0u) { if (xb_ld(&(bar)[XB_TMO])) break; if (_sp > XB_SPIN_CAP) { atomicAdd(&(bar)[XB_TMO], 1u); break; } } } } while (0)

struct XcdBarrier {
    unsigned* bar; unsigned x;
    volatile LAS unsigned* st;
};

__device__ __forceinline__ XcdBarrier xcd_barrier_post(unsigned* bar, volatile LAS unsigned* st) {
    XcdBarrier b; b.bar = bar; b.x = xb_xcc_id(); b.st = st;
    if (threadIdx.x == 0) (void)xb_add(&bar[XB_XCNT(b.x)], 1u);
    return b;
}
__device__ __forceinline__ void xcd_barrier_complete(unsigned* bar, unsigned x, unsigned& nloc, unsigned& nx) {
    const unsigned G = gridDim.x * gridDim.y * gridDim.z;
    unsigned sum, cnt, mine, sp = 0u;
    for (;;) {
        sum = 0u; cnt = 0u; mine = 0u;
#pragma unroll
        for (unsigned j = 0; j < 16; ++j) { const unsigned c = xb_ld(&bar[XB_XCNT(j)]); sum += c; cnt += (c > 0u) ? 1u : 0u; mine = (j == x) ? c : mine; }
        if (sum == G) break;
        __builtin_amdgcn_s_sleep(1);
        if ((++sp & 255u) == 0u) { if (xb_ld(&bar[XB_TMO])) break; if (sp > XB_SPIN_CAP) { atomicAdd(&bar[XB_TMO], 1u); break; } }
    }
    nloc = mine > 0u ? mine : 1u; nx = cnt > 0u ? cnt : 1u;
}

__device__ __forceinline__ void xcd_barrier(const XcdBarrier& b) {
    asm volatile("s_waitcnt vmcnt(0)" ::: "memory");
    __syncthreads();
    if (threadIdx.x == 0) {
        unsigned* bar = b.bar;
        __builtin_amdgcn_s_waitcnt(0);
        unsigned nloc = b.st[0], nx = b.st[1];
        if (nloc == 0u) { xcd_barrier_complete(bar, b.x, nloc, nx); b.st[0] = nloc; b.st[1] = nx; }
        const unsigned old = xb_add(&bar[XB_XSUB(b.x)], 1u);
        const unsigned gen = old / nloc;
        if (old + 1u == (gen + 1u) * nloc) {
            __builtin_amdgcn_fence(__ATOMIC_RELEASE, "agent");
            asm volatile("s_waitcnt vmcnt(0)" ::: "memory");
            const unsigned og = xb_add(&bar[XB_TOP], 1u);
            const unsigned tg = og / nx;
            if (og + 1u == (tg + 1u) * nx) xb_add(&bar[XB_TOPGEN], 1u);
            else XB_SPIN(xb_ld(&bar[XB_TOPGEN]) == tg, bar);
            __builtin_amdgcn_fence(__ATOMIC_ACQUIRE, "agent");
            xb_add(&bar[XB_XGEN(b.x)], 1u);
            asm volatile("s_waitcnt vmcnt(0)" ::: "memory");
        } else {
            XB_SPIN(xb_ld(&bar[XB_XGEN(b.x)]) == gen, bar);
            __builtin_amdgcn_fence(__ATOMIC_ACQUIRE, "agent");
            asm volatile("s_waitcnt vmcnt(0)" ::: "memory");
        }
    }
    __syncthreads();
}
constexpr int NWAVES = 8;
constexpr int NB = 8, SEQ = 4096, DM = 1024, TOK = NB * SEQ, INW = 4864;
constexpr float EPS = 1e-6f;
constexpr size_t MiB = 1u << 20;
constexpr size_t WS_CTL = 0, CTL_ZERO_BYTES = 1 * MiB;
constexpr size_t WS_MODP = 1 * MiB;
constexpr size_t WS_ROPE = 3 * MiB;
constexpr size_t WS_WIN = 4 * MiB, WS_WPA = 14 * MiB, WS_WPR = 15 * MiB, WS_WOUT = 16 * MiB;
constexpr size_t WS_H = 32 * MiB;
constexpr size_t WS_Q = 96 * MiB;
constexpr size_t WS_K = 128 * MiB, WS_V = 136 * MiB;
constexpr size_t WS_SZA = 144 * MiB;
constexpr size_t WS_RQ = 176 * MiB, WS_RK = 192 * MiB, WS_RV = 208 * MiB;
constexpr size_t WS_Y = 176 * MiB;
constexpr size_t WS_SZR = 240 * MiB;
constexpr size_t WS_G = 272 * MiB;
constexpr size_t WS_YR = 400 * MiB;
constexpr size_t WS_ST = 432 * MiB;
constexpr size_t WS_END = 496 * MiB;
constexpr int CW_BAR = 4096;
constexpr int RING_OFF = 0, RING_BYTES = 131072;
constexpr int LDSCTL_OFF = RING_BYTES, MISC_OFF = LDSCTL_OFF + 320;
constexpr int LDS_BYTES = 147456;
static_assert(ret::L_END <= RING_BYTES && attn_body::ATTN_LDS_BYTES <= RING_BYTES, "phase scratch inside the ring region");

__device__ __forceinline__ float wave_sum(float v) {
#pragma unroll
    for (int o = 1; o < 64; o <<= 1) v += __shfl_xor(v, o);
    return v;
}
__device__ __forceinline__ int drow(int n, int mode) {
    const int tile = n >> 8, w = n & 255, wc = w >> 6, bj = (w >> 5) & 1, jj = n & 31;
    const bool rope = mode && (tile == 0 || tile == 1 || tile == 5 || tile == 6 || (tile == 2 && wc < 2));
    const int pj = rope ? jj : (((jj >> 2) & 1) * 16 + (jj >> 3) * 4 + (jj & 3));
    return tile * 256 + bj * 128 + wc * 32 + pj;
}
__device__ __forceinline__ void p0_transpose_item(const float* W, int N, bf16* WT, int ldk, LAS float* scr, int item, int lane, int mode) {
    const int nblk = N / 32, kb = item / nblk, nb = item % nblk, k0 = 64 * kb, n0 = 32 * nb;
#pragma unroll 8
    for (int i = 0; i < 32; ++i) { const int kk = 2 * i + (lane >> 5); scr[kk * 33 + (lane & 31)] = W[(size_t)(k0 + kk) * N + n0 + (lane & 31)]; }
    LDS_WAIT(); asm volatile("" ::: "memory");
    const int c = lane & 7;
#pragma unroll
    for (int j = 0; j < 4; ++j) { const int n = (lane >> 3) + 8 * j; const LAS float* s = scr + (8 * c) * 33 + n;
        v4u o; o.x = pk2(s[0 * 33], s[1 * 33]); o.y = pk2(s[2 * 33], s[3 * 33]); o.z = pk2(s[4 * 33], s[5 * 33]); o.w = pk2(s[6 * 33], s[7 * 33]);
        *(GAS v4u*)(WT + (size_t)drow(n0 + n, mode) * ldk + k0 + 8 * c) = o; }
    LDS_WAIT(); asm volatile("" ::: "memory");
}

struct Args { const float* in[15]; float* out; unsigned char* ws; };

__global__ void __launch_bounds__(NWAVES * 64, 2) fwd_mega(Args args) {
    extern __shared__ __attribute__((aligned(16))) unsigned char lds_raw[];
    LAS unsigned char* lds = (LAS unsigned char*)lds_raw;
    volatile LAS unsigned* MISC = (volatile LAS unsigned*)(lds + MISC_OFF);
    const int tid = threadIdx.x, lane = tid & 63, wave = __builtin_amdgcn_readfirstlane(tid >> 6);
    const int G = gridDim.x; const int bx = blockIdx.x; const int vcu = (G % 8 == 0) ? (bx % 8) * (G / 8) + bx / 8 : bx;
    gu32* ctl = (gu32*)(args.ws + WS_CTL);
#define P_x      (args.in[0])
#define P_cvec   (args.in[1])
#define P_w_ada  (args.in[2])
#define P_b_ada  (args.in[3])
#define P_g_pre  (args.in[4])
#define P_w_in   (args.in[5])
#define P_qn_g   (args.in[6])
#define P_kn_g   (args.in[7])
#define P_w_dec_f (args.in[8])
#define P_w_dec_b (args.in[9])
#define P_gn_g   (args.in[10])
#define P_w_pa   (args.in[11])
#define P_w_pr   (args.in[12])
#define P_w_out  (args.in[13])
#define P_g_post (args.in[14])
#define P_out    (args.out)
#define P_MODP   ((float*)(args.ws + WS_MODP))
#define P_ROPE   ((float*)(args.ws + WS_ROPE))
#define P_WIN_T  ((bf16*)(args.ws + WS_WIN))
#define P_WPA_T  ((bf16*)(args.ws + WS_WPA))
#define P_WPR_T  ((bf16*)(args.ws + WS_WPR))
#define P_WOUT_T ((bf16*)(args.ws + WS_WOUT))
#define P_HB     ((bf16*)(args.ws + WS_H))
#define P_QB_    ((bf16*)(args.ws + WS_Q))
#define P_KB     ((bf16*)(args.ws + WS_K))
#define P_VB     ((bf16*)(args.ws + WS_V))
#define P_SZA    ((bf16*)(args.ws + WS_SZA))
#define P_RQ     ((bf16*)(args.ws + WS_RQ))
#define P_RK     ((bf16*)(args.ws + WS_RK))
#define P_RV     ((bf16*)(args.ws + WS_RV))
#define P_YB     ((bf16*)(args.ws + WS_Y))
#define P_SZR    ((bf16*)(args.ws + WS_SZR))
#define P_GB     ((bf16*)(args.ws + WS_G))
#define P_YR     ((bf16*)(args.ws + WS_YR))
#define P_ST     ((float*)(args.ws + WS_ST))
    for (int u = tid; u < (LDS_BYTES - LDSCTL_OFF) / 4; u += NWAVES * 64) ((LAS unsigned*)(lds + LDSCTL_OFF))[u] = 0u;
    __syncthreads();
    XcdBarrier bar = xcd_barrier_post((unsigned*)(ctl + CW_BAR), MISC + 8);
    const int gw = vcu * NWAVES + wave, NGW = G * NWAVES;

    {
        LAS float* scr = (LAS float*)(lds + RING_OFF + wave * 16384);
        constexpr int I_IN = (DM / 64) * (INW / 32), I_PA = (512 / 64) * (DM / 32), I_OUT = (DM / 64) * (DM / 32), I_MOD = 48 * 16, I_ROPE = 16;
        constexpr int NITEMS = I_IN + 2 * I_PA + I_OUT + I_MOD + I_ROPE;
        for (int it = gw; it < NITEMS; it += NGW) {
            int r = it;
            if (r < I_IN) { p0_transpose_item(P_w_in, INW, P_WIN_T, DM, scr, r, lane, 1); continue; } r -= I_IN;
            if (r < I_PA) { p0_transpose_item(P_w_pa, DM, P_WPA_T, 512, scr, r, lane, 0); continue; } r -= I_PA;
            if (r < I_PA) { p0_transpose_item(P_w_pr, DM, P_WPR_T, 512, scr, r, lane, 0); continue; } r -= I_PA;
            if (r < I_OUT) { p0_transpose_item(P_w_out, DM, P_WOUT_T, DM, scr, r, lane, 0); continue; } r -= I_OUT;
            if (r < I_MOD) {
                const int cg = r % 48, ks = r / 48, col = 64 * cg + lane;
                float a[8];
#pragma unroll
                for (int b = 0; b < 8; ++b) a[b] = (ks == 0) ? P_b_ada[col] : 0.f;
                for (int kk = 0; kk < 64; ++kk) { const int k = 64 * ks + kk; const float w = P_w_ada[(size_t)k * 3072 + col];
#pragma unroll
                    for (int b = 0; b < 8; ++b) { const float cv = P_cvec[b * DM + k]; a[b] += pg8::silu_f(cv) * w; } }
#pragma unroll
                for (int b = 0; b < 8; ++b) P_MODP[(size_t)(ks * 8 + b) * 3072 + col] = a[b];
                continue; }
            r -= I_MOD;
            {   const int idx = r * 64 + lane, pos = idx >> 4, f = idx & 15;
                const float invf = exp2f(-(float)f * (13.287712379549449f / 16.0f));
                const float ang = (float)pos * invf;
                double rev = (double)ang * 0.15915494309189535; rev -= floor(rev);
                const float rv = (float)rev;
                P_ROPE[2 * idx] = __builtin_amdgcn_cosf(rv); P_ROPE[2 * idx + 1] = __builtin_amdgcn_sinf(rv); }
        }
    }
    xcd_barrier(bar);

    {
        LAS float* sA = (LAS float*)(lds + RING_OFF); LAS float* sB = sA + DM;
        for (int rb = vcu; rb < TOK / 128; rb += G) {
            const int b = rb >> 5;
            __syncthreads();
            for (int k = tid; k < DM; k += NWAVES * 64) { float sh = 0.f, sc = 0.f;
                for (int ks = 0; ks < 16; ++ks) { sh += P_MODP[(size_t)(ks * 8 + b) * 3072 + k]; sc += P_MODP[(size_t)(ks * 8 + b) * 3072 + 1024 + k]; }
                sA[k] = P_g_pre[k] * (1.0f + sc); sB[k] = sh; }
            __syncthreads();
            for (int rr = 0; rr < 16; ++rr) {
                const size_t row = (size_t)rb * 128 + wave * 16 + rr;
                const GAS f32x4* xr = (const GAS f32x4*)(P_x + row * DM) + lane;
                f32x4 v[4]; float s = 0.f;
#pragma unroll
                for (int j = 0; j < 4; ++j) { v[j] = xr[64 * j]; s += (v[j].x * v[j].x + v[j].y * v[j].y) + (v[j].z * v[j].z + v[j].w * v[j].w); }
                const float rstd = 1.0f / sqrtf(wave_sum(s) * (1.f / DM) + EPS);
                GAS unsigned long long* o8 = (GAS unsigned long long*)(P_HB + row * DM) + lane;
#pragma unroll
                for (int j = 0; j < 4; ++j) { const int k = 4 * lane + 256 * j; const f32x4 a = *(LAS f32x4*)(sA + k), bb = *(LAS f32x4*)(sB + k);
                    o8[64 * j] = (unsigned long long)pk2(v[j].x * rstd * a.x + bb.x, v[j].y * rstd * a.y + bb.y) | ((unsigned long long)pk2(v[j].z * rstd * a.z + bb.z, v[j].w * rstd * a.w + bb.w) << 32); }
            }
        }
        __syncthreads();
    }
    xcd_barrier(bar);

    {
        pg8::Gemm g{P_HB, P_WIN_T, TOK, INW, DM}; pg8::StaticOrder S; S.init(TOK, INW, G, bx);
        pg8::EpiIn E{P_QB_, P_KB, P_VB, P_SZA, P_RQ, P_RK, P_RV, P_SZR, P_GB, P_qn_g, P_kn_g, P_ROPE};
        pg8::gemm_phase<pg8::EpiIn, pg8::StaticOrder, PG8_ALIGN, PG8_SP2>(lds + RING_OFF, g, S, E);
    }
    xcd_barrier(bar);

    for (int it = vcu; it < 256; it += G) {
        const int h = (it >> 3) & 3;
        const float lg2f = -log1pf(expf(-P_w_dec_f[h])) * pg8::LOG2E, lg2b = -log1pf(expf(-P_w_dec_b[h])) * pg8::LOG2E;
        ret::pass1_item(it, P_RK, P_RV, P_ST, lg2f, lg2b, (LAS char*)(lds + RING_OFF));
    }
    __syncthreads();
    xcd_barrier(bar);

    {
        const attn_body::AttnTensors AT{(const attn_body::bf16*)P_QB_, (const attn_body::bf16*)P_KB, (const attn_body::bf16*)P_VB, (const attn_body::bf16*)P_SZA, (attn_body::bf16*)P_QB_};
        const attn_body::StaticOrder S(G, bx);
        attn_body::attn_phase<attn_body::StaticOrder>((char*)lds_raw + RING_OFF, AT, S);
    }
    for (int it = vcu; it < 256; it += G) {
        const int h = (it >> 3) & 3;
        const float lg2f = -log1pf(expf(-P_w_dec_f[h])) * pg8::LOG2E, lg2b = -log1pf(expf(-P_w_dec_b[h])) * pg8::LOG2E;
        ret::pass2_item(it, P_RQ, P_RK, P_RV, P_SZR, P_ST, P_gn_g, lg2f, lg2b, P_YR, (LAS char*)(lds + RING_OFF));
    }
    __syncthreads();
    xcd_barrier(bar);

    {
        pg8::StaticOrder S; S.init(TOK, DM, G, bx);
        { pg8::Gemm g{P_QB_, P_WPA_T, TOK, DM, 512}; pg8::EpiMerge<0> E{P_HB, P_GB, DM, 2048, 0};
          pg8::gemm_phase<pg8::EpiMerge<0>, pg8::StaticOrder, PG8_ALIGN, PG8_SP2>(lds + RING_OFF, g, S, E); }
        { pg8::Gemm g{P_YR, P_WPR_T, TOK, DM, 512}; pg8::EpiMerge<1> E{P_HB, P_GB, DM, 2048, 1024};
          pg8::gemm_phase<pg8::EpiMerge<1>, pg8::StaticOrder, PG8_ALIGN, PG8_SP2>(lds + RING_OFF, g, S, E); }
    }
    xcd_barrier(bar);

    {
        pg8::StaticOrder S; S.init(TOK, DM, G, bx);
        pg8::Gemm g{P_HB, P_WOUT_T, TOK, DM, DM}; pg8::EpiMerge<2> E{P_YB, nullptr, DM, 0, 0};
        pg8::gemm_phase<pg8::EpiMerge<2>, pg8::StaticOrder, PG8_ALIGN, PG8_SP2>(lds + RING_OFF, g, S, E);
    }
    xcd_barrier(bar);

    {
        LAS float* sA = (LAS float*)(lds + RING_OFF);
        const unsigned dead = xb_ld((unsigned*)(ctl + CW_BAR) + XB_TMO);
        for (int rb = vcu; rb < TOK / 128; rb += G) {
            const int b = rb >> 5;
            __syncthreads();
            for (int k = tid; k < DM; k += NWAVES * 64) { float gt = 0.f;
                for (int ks = 0; ks < 16; ++ks) gt += P_MODP[(size_t)(ks * 8 + b) * 3072 + 2048 + k];
                sA[k] = gt * P_g_post[k]; }
            __syncthreads();
            for (int rr = 0; rr < 16; ++rr) {
                const size_t row = (size_t)rb * 128 + wave * 16 + rr;
                const GAS unsigned long long* yr8 = (const GAS unsigned long long*)(P_YB + row * DM) + lane;
                f32x4 v[4]; float s = 0.f;
#pragma unroll
                for (int j = 0; j < 4; ++j) { const unsigned long long w = yr8[64 * j]; const unsigned lo = (unsigned)w, hi = (unsigned)(w >> 32);
                    v[j] = (f32x4){__uint_as_float(lo << 16), __uint_as_float(lo & 0xffff0000u), __uint_as_float(hi << 16), __uint_as_float(hi & 0xffff0000u)};
                    s += (v[j].x * v[j].x + v[j].y * v[j].y) + (v[j].z * v[j].z + v[j].w * v[j].w); }
                const float rstd = 1.0f / sqrtf(wave_sum(s) * (1.f / DM) + EPS);
                const GAS f32x4* xr = (const GAS f32x4*)(P_x + row * DM) + lane; GAS f32x4* orow = (GAS f32x4*)(P_out + row * DM) + lane;
#pragma unroll
                for (int j = 0; j < 4; ++j) { const int k = 4 * lane + 256 * j; const f32x4 a = *(LAS f32x4*)(sA + k); f32x4 o = xr[64 * j] + v[j] * rstd * a;
                    if (dead) { const float q = __builtin_nanf(""); o = (f32x4){q, q, q, q}; }
                    orow[64 * j] = o; }
            }
        }
    }
}

#undef P_x
#undef P_cvec
#undef P_w_ada
#undef P_b_ada
#undef P_g_pre
#undef P_w_in
#undef P_qn_g
#undef P_kn_g
#undef P_w_dec_f
#undef P_w_dec_b
#undef P_gn_g
#undef P_w_pa
#undef P_w_pr
#undef P_w_out
#undef P_g_post
#undef P_out
#undef P_MODP
#undef P_ROPE
#undef P_WIN_T
#undef P_WPA_T
#undef P_WPR_T
#undef P_WOUT_T
#undef P_HB
#undef P_QB_
#undef P_KB
#undef P_VB
#undef P_SZA
#undef P_RQ
#undef P_RK
#undef P_RV
#undef P_YB
#undef P_SZR
#undef P_GB
#undef P_YR
#undef P_ST
extern "C" void kernel_launch(void* const* d_in, const int* in_sizes, int n_in, void* d_out, int out_size, void* d_ws, size_t ws_size, hipStream_t stream) {
    static int grid = 0;
    if (grid == 0) {
        if (n_in != 15 || in_sizes[0] != TOK * DM || out_size != TOK * DM || ws_size < WS_END) { fprintf(stderr, "kernel_launch: unexpected shapes (n_in %d, in0 %d, out %d, ws %zu); nothing launched\n", n_in, n_in > 0 ? in_sizes[0] : -1, out_size, ws_size); grid = -1; return; }
        int dev = 0, cus = 0, per_cu = 0;
        if (hipGetDevice(&dev) != hipSuccess || hipDeviceGetAttribute(&cus, hipDeviceAttributeMultiprocessorCount, dev) != hipSuccess) { fprintf(stderr, "kernel_launch: device query failed\n"); grid = -1; return; }
        if (hipFuncSetAttribute((const void*)fwd_mega, hipFuncAttributeMaxDynamicSharedMemorySize, LDS_BYTES) != hipSuccess) { fprintf(stderr, "kernel_launch: hipFuncSetAttribute failed\n"); grid = -1; return; }
        if (hipOccupancyMaxActiveBlocksPerMultiprocessor(&per_cu, (const void*)fwd_mega, NWAVES * 64, LDS_BYTES) != hipSuccess || per_cu < 1) { fprintf(stderr, "kernel_launch: occupancy query says %d blocks per CU; nothing launched\n", per_cu); (void)hipGetLastError(); grid = -1; return; }
        grid = cus;
        if (grid > 256) grid = 256;
    }
    if (grid < 0) return;
    if (hipMemsetAsync((char*)d_ws + WS_CTL, 0, CTL_ZERO_BYTES, stream) != hipSuccess) { fprintf(stderr, "kernel_launch: memset failed\n"); return; }
    Args a{};
    for (int i = 0; i < 15; ++i) a.in[i] = (const float*)d_in[i];
    a.out = (float*)d_out; a.ws = (unsigned char*)d_ws;
    hipLaunchKernelGGL(fwd_mega, dim3(grid), dim3(NWAVES * 64), LDS_BYTES, stream, a);
    const hipError_t le = hipPeekAtLastError();
    if (le != hipSuccess) fprintf(stderr, "kernel_launch: launch failed: %s\n", hipGetErrorName(le));
}
```
